# Optimizing an MI355X kernel written in HIP

```python
import jax, jax.numpy as jnp
from jax import lax
import numpy as np

D_MODEL = 2048
BATCH = 8
SEQ = 2048
DEPTH = 1
DEC_BATCH = 128
DEC_SEQ = 8
PAST_LEN = 16384
PAGE_SIZE = 128

D_CONV = D_MODEL // 2
CONV_W = 3
HEAD_DIM = 64
D_ATTN = D_MODEL // 2
N_HEADS = D_ATTN // HEAD_DIM
N_KV_HEADS = N_HEADS // 4
GROUP = N_HEADS // N_KV_HEADS
D_KV = N_KV_HEADS * HEAD_DIM
WINDOW = 128
BLOCK = WINDOW
LN_EPS = 1e-5
ALPHA = (2 * DEPTH) ** 0.25
BETA = (8 * DEPTH) ** -0.25
NEG = -1e30
SPLIT_SIZES = (D_CONV, D_CONV, D_CONV, D_CONV, D_ATTN, D_KV, D_KV, D_ATTN, D_MODEL, D_MODEL)
D_IN_TOTAL = sum(SPLIT_SIZES)
SPLIT_OFFSETS = tuple(int(o) for o in np.cumsum(SPLIT_SIZES)[:-1])

kernel_name = "hybrid_shortconv_swa_sink_alibi_deepnorm_step"


def layer_norm(x, g, b):
    xf = x.astype(jnp.float32)
    mu = jnp.mean(xf, axis=-1, keepdims=True)
    var = jnp.mean(jnp.square(xf - mu), axis=-1, keepdims=True)
    y = (xf - mu) * lax.rsqrt(var + LN_EPS) * g.astype(jnp.float32) + b.astype(jnp.float32)
    return y.astype(x.dtype)


def alibi_slopes():
    h = jnp.arange(1, N_HEADS + 1, dtype=jnp.float32)
    return (2.0 ** (-8.0 * h / N_HEADS)).reshape(N_KV_HEADS, GROUP)


def short_conv(u, prev, conv_w):
    L = u.shape[1]
    u_pad = jnp.concatenate([prev.astype(u.dtype), u], axis=1)
    y = conv_w[0] * u_pad[:, 0:L]
    for tap in range(1, CONV_W):
        y = y + conv_w[tap] * u_pad[:, tap:tap + L]
    return y, u_pad[:, -(CONV_W - 1):]


def sink_window_attend(q, k, v, delta, valid, sinks):
    s = jnp.einsum('...qkgd,...skd->...kgqs', q.astype(jnp.float32), k.astype(jnp.float32)) * (HEAD_DIM ** -0.5)
    s = s - alibi_slopes()[:, :, None, None] * delta
    s = jnp.where(valid, s, NEG)
    sink = sinks.astype(jnp.float32).reshape(N_KV_HEADS, GROUP)[:, :, None, None]
    m = jnp.maximum(jnp.max(s, axis=-1, keepdims=True), sink)
    p = jnp.exp(s - m)
    denom = jnp.sum(p, axis=-1, keepdims=True) + jnp.exp(sink - m)
    o = jnp.einsum('...kgqs,...skd->...qkgd', p / denom, v.astype(jnp.float32))
    return o.astype(q.dtype)


def prompt_window_attention(q, k, v, sinks):
    b, L = q.shape[0], q.shape[1]
    nb = L // BLOCK
    qb = q.reshape(b, nb, BLOCK, N_KV_HEADS, GROUP, HEAD_DIM)
    kb = k.reshape(b, nb, BLOCK, N_KV_HEADS, HEAD_DIM)
    vb = v.reshape(b, nb, BLOCK, N_KV_HEADS, HEAD_DIM)

    def band(t):
        prev = jnp.concatenate([jnp.zeros_like(t[:, :1]), t[:, :-1]], axis=1)
        return jnp.concatenate([prev, t], axis=2)

    i = jnp.arange(BLOCK)[:, None]
    j = jnp.arange(2 * BLOCK)[None, :]
    delta = BLOCK + i - j
    blk = jnp.arange(nb)[:, None, None]
    valid = (delta >= 0) & (delta <= WINDOW) & ((blk > 0) | (j >= BLOCK))
    o = sink_window_attend(qb, band(kb), band(vb), delta.astype(jnp.float32),
                           valid[:, None, None], sinks)
    return o.reshape(b, L, D_ATTN), k[:, -WINDOW:], v[:, -WINDOW:]


def sample_window_attention(q, k, v, sinks, cache_k, cache_v):
    b, lq = q.shape[0], q.shape[1]
    k_all = jnp.concatenate([cache_k.astype(k.dtype), k], axis=1)
    v_all = jnp.concatenate([cache_v.astype(v.dtype), v], axis=1)
    i = jnp.arange(lq)[:, None]
    j = jnp.arange(WINDOW + lq)[None, :]
    delta = WINDOW + i - j
    valid = (delta >= 0) & (delta <= WINDOW)
    o = sink_window_attend(q, k_all, v_all, delta.astype(jnp.float32), valid, sinks)
    return o.reshape(b, lq, D_ATTN), k_all[:, -WINDOW:], v_all[:, -WINDOW:]


def hybrid_layer(x, conv_prev, attend_fn, w_in, conv_w, w_conv_out, w_attn_out, w_out, ln_g, ln_b):
    bsz, L, _ = x.shape
    proj = jnp.einsum('bld,de->ble', x, w_in)
    gb, gc, h, z_c, q, k, v, z_a, gate_c, gate_a = jnp.split(proj, SPLIT_OFFSETS, axis=-1)
    conv_out, conv_state = short_conv(gc * h, conv_prev, conv_w)
    y_c = jax.nn.silu(z_c) * gb * conv_out
    q = q.reshape(bsz, L, N_KV_HEADS, GROUP, HEAD_DIM)
    k = k.reshape(bsz, L, N_KV_HEADS, HEAD_DIM)
    v = v.reshape(bsz, L, N_KV_HEADS, HEAD_DIM)
    o, k_state, v_state = attend_fn(q, k, v)
    y_a = jax.nn.silu(z_a) * o
    merged = (jax.nn.sigmoid(gate_c) * jnp.einsum('blc,cd->bld', y_c, w_conv_out)
              + jax.nn.sigmoid(gate_a) * jnp.einsum('bla,ad->bld', y_a, w_attn_out))
    out = jnp.einsum('bld,de->ble', merged, w_out)
    y = layer_norm(ALPHA * x + out, ln_g, ln_b)
    return y, k_state, v_state, conv_state


def setup_inputs(seed: int = 0) -> dict:
    key = jax.random.key(seed)
    ks = jax.random.split(key, 16)
    f32 = jnp.float32
    col_scale = jnp.asarray(np.concatenate([
        np.full(D_CONV, 1.0), np.full(D_CONV, 1.0), np.full(D_CONV, BETA), np.full(D_CONV, 1.0),
        np.full(D_ATTN, 1.0), np.full(D_KV, 1.0), np.full(D_KV, BETA), np.full(D_ATTN, 1.0),
        np.full(D_MODEL, 1.0), np.full(D_MODEL, 1.0)]).astype(np.float32))
    x_prompt = jax.random.normal(ks[0], (BATCH, SEQ, D_MODEL), f32)
    x_sample = jax.random.normal(ks[1], (DEC_BATCH, DEC_SEQ, D_MODEL), f32)
    cache_k = jax.random.normal(ks[2], (DEPTH, DEC_BATCH, WINDOW, N_KV_HEADS, HEAD_DIM), f32)
    cache_v = jax.random.normal(ks[3], (DEPTH, DEC_BATCH, WINDOW, N_KV_HEADS, HEAD_DIM), f32) * BETA
    state_conv = jax.random.normal(ks[4], (DEPTH, DEC_BATCH, CONV_W - 1, D_CONV), f32) * BETA
    w_in = jax.random.normal(ks[5], (DEPTH, D_MODEL, D_IN_TOTAL), f32) * (D_MODEL ** -0.5) * col_scale
    conv_w = jax.random.normal(ks[6], (DEPTH, CONV_W, D_CONV), f32) * (CONV_W ** -0.5)
    attn_sinks = jax.random.normal(ks[7], (DEPTH, N_HEADS), f32) * 0.5
    w_conv_out = jax.random.normal(ks[8], (DEPTH, D_CONV, D_MODEL), f32) * (D_CONV ** -0.5) * BETA
    w_attn_out = jax.random.normal(ks[9], (DEPTH, D_ATTN, D_MODEL), f32) * (D_ATTN ** -0.5) * BETA
    w_out = jax.random.normal(ks[10], (DEPTH, D_MODEL, D_MODEL), f32) * (D_MODEL ** -0.5) * BETA
    ln_g = 1.0 + 0.02 * jax.random.normal(ks[11], (DEPTH, D_MODEL), f32)
    ln_b = 0.02 * jax.random.normal(ks[12], (DEPTH, D_MODEL), f32)
    return {"x_prompt": x_prompt, "x_sample": x_sample, "cache_k": cache_k, "cache_v": cache_v,
            "state_conv": state_conv, "w_in": w_in, "conv_w": conv_w, "attn_sinks": attn_sinks,
            "w_conv_out": w_conv_out, "w_attn_out": w_attn_out, "w_out": w_out,
            "ln_g": ln_g, "ln_b": ln_b}


def reference(x_prompt, x_sample, cache_k, cache_v, state_conv, w_in, conv_w, attn_sinks,
              w_conv_out, w_attn_out, w_out, ln_g, ln_b):
    xp, xs = x_prompt, x_sample
    kp_l, vp_l, cp_l, ks_l, vs_l, cs_l = [], [], [], [], [], []
    for l in range(DEPTH):
        sinks = attn_sinks[l]
        conv_zero = jnp.zeros((xp.shape[0], CONV_W - 1, D_CONV), xp.dtype)
        xp, kp, vp, cp = hybrid_layer(
            xp, conv_zero,
            lambda q, k, v, s_=sinks: prompt_window_attention(q, k, v, s_),
            w_in[l], conv_w[l], w_conv_out[l], w_attn_out[l], w_out[l], ln_g[l], ln_b[l])
        ck, cv = cache_k[l], cache_v[l]
        xs, k_s, v_s, c_s = hybrid_layer(
            xs, state_conv[l],
            lambda q, k, v, s_=sinks, ck_=ck, cv_=cv: sample_window_attention(q, k, v, s_, ck_, cv_),
            w_in[l], conv_w[l], w_conv_out[l], w_attn_out[l], w_out[l], ln_g[l], ln_b[l])
        kp_l.append(kp); vp_l.append(vp); cp_l.append(cp)
        ks_l.append(k_s); vs_l.append(v_s); cs_l.append(c_s)
    k_prompt = jnp.stack(kp_l)
    v_prompt = jnp.stack(vp_l)
    conv_prompt = jnp.stack(cp_l)
    k_sample = jnp.stack(ks_l)
    v_sample = jnp.stack(vs_l)
    conv_sample = jnp.stack(cs_l)
    return (xp, xs, k_prompt, v_prompt, conv_prompt, k_sample, v_sample, conv_sample)
```

```cpp
#include <hip/hip_runtime.h>
#include <hip/hip_cooperative_groups.h>
#include <cstdio>
#include <cstdint>
namespace cg = cooperative_groups;

#define LAS __attribute__((address_space(3)))
typedef unsigned short bf16_t;
typedef short bf16x8 __attribute__((ext_vector_type(8)));
typedef short s16x4 __attribute__((ext_vector_type(4)));
typedef float f32x4 __attribute__((ext_vector_type(4)));
typedef float f32x16 __attribute__((ext_vector_type(16)));
typedef unsigned u32x4 __attribute__((ext_vector_type(4)));
typedef unsigned u32x2 __attribute__((ext_vector_type(2)));
typedef int i32x4 __attribute__((ext_vector_type(4)));
typedef int i32x8 __attribute__((ext_vector_type(8)));

constexpr int DM = 2048, MP = 16384, MS = 1024, MT = MP + MS, NIN = 10752, SEQ = 2048;
constexpr float LOG2E = 1.4426950408889634f;
constexpr float QSCALE = 0.125f * LOG2E;
constexpr float ALPHA = 1.189207115002721f;
constexpr float LN_EPS = 1e-5f;
constexpr float WSC = 64.f, MSC = 16.f, XSC = 8.f, YCSC = 8.f, YASC = 16.f;
constexpr size_t O_Y = 0, O_KP = (size_t)MT * DM, O_VP = O_KP + 8 * 128 * 256, O_CP = O_VP + 8 * 128 * 256, O_KS = O_CP + 8 * 2 * 1024,
                 O_VS = O_KS + (size_t)128 * 128 * 256, O_CS = O_VS + (size_t)128 * 128 * 256, O_END = O_CS + 128 * 2 * 1024;
constexpr int NB16 = 2560, NF8 = 8192;
constexpr size_t W_W1B = 0;
constexpr size_t W_W18 = W_W1B + (size_t)NB16 * DM * 2;
constexpr size_t W_W2T = W_W18 + (size_t)(NF8 + NB16) * DM;
constexpr size_t W_W3T = W_W2T + 2ull * DM * 1024;
constexpr size_t W_XB = W_W3T + (size_t)DM * DM;
constexpr size_t W_X8 = W_XB + (size_t)MT * DM * 2;
constexpr size_t W_S = W_X8 + (size_t)MT * DM;
constexpr size_t W_U = W_S + (size_t)MT * 1024 * 2;
constexpr size_t W_Q = W_U + (size_t)MT * 1024 * 2;
constexpr size_t W_K = W_Q + (size_t)MT * 1024 * 2;
constexpr size_t W_V = W_K + (size_t)MT * 256 * 2;
constexpr size_t W_ZA = W_V + (size_t)MT * 256 * 2;
constexpr size_t W_GC = W_ZA + (size_t)MT * 1024 * 2;
constexpr size_t W_GA = W_GC + (size_t)MT * DM * 2;
constexpr size_t W_YCA = W_GA + (size_t)MT * DM * 2;
constexpr size_t W_CTL = W_YCA + 2ull * MT * 1024;
constexpr size_t CTL_BYTES = 16384;
constexpr size_t W_END = W_CTL + CTL_BYTES;
constexpr int LDS_BYTES = 147456;

__device__ __forceinline__ unsigned cvt_pk_bf16(float lo, float hi) { unsigned r; asm volatile("v_cvt_pk_bf16_f32 %0, %1, %2" : "=v"(r) : "v"(lo), "v"(hi)); return r; }
__device__ __forceinline__ float bf_lo(unsigned u) { return __uint_as_float(u << 16); }
__device__ __forceinline__ float bf_hi(unsigned u) { return __uint_as_float(u & 0xffff0000u); }
__device__ __forceinline__ unsigned pk4_fp8(float a, float b, float c, float d) {
    a = __builtin_amdgcn_fmed3f(a, -448.f, 448.f); b = __builtin_amdgcn_fmed3f(b, -448.f, 448.f); c = __builtin_amdgcn_fmed3f(c, -448.f, 448.f); d = __builtin_amdgcn_fmed3f(d, -448.f, 448.f);
    unsigned w = 0u; w = __builtin_amdgcn_cvt_pk_fp8_f32(a, b, w, false); w = __builtin_amdgcn_cvt_pk_fp8_f32(c, d, w, true); return w; }
__device__ __forceinline__ float sigm(float x) { return __builtin_amdgcn_rcpf(1.0f + __builtin_amdgcn_exp2f(-x * LOG2E)); }

namespace pg8 {
constexpr int BM = 256, BK = 64, HALF = 128, HTB = HALF * BK * 2, STAGE_BYTES = 8 * HTB, NXCD = 8, WGM = 8;
__host__ __device__ __forceinline__ int lds_byte(int r, int c) { const int st = (r >> 4) * 2 + (c >> 5), rr = r & 15, cc = c & 31, ob = rr * 64 + cc * 2; return st * 1024 + (ob ^ (((ob >> 9) & 1) << 5)); }
__host__ __device__ __forceinline__ void stage_rc(int b, int& R, int& C) { const int st = b / 1024, sb = b % 1024, swz = sb ^ (((sb >> 9) & 1) << 5); R = (st >> 1) * 16 + swz / 64; C = (st & 1) * 32 + (swz % 64) / 2; }
__host__ __device__ __forceinline__ int perm32(int rho) { const int n = rho >> 4, i = rho & 15; return 8 * (i >> 2) + 4 * n + (i & 3); }

struct Unit { int pm, pn, z; };
struct Gemm { const bf16_t* A; const bf16_t* Bt; int M, N, K; size_t zA, zB; int ld; };

struct StaticOrder {
    int nM, nN, nwg, G, c;
    __device__ void init(int M, int N, int G_, int c_) { nM = M / BM; nN = N / BM; nwg = nM * nN; G = G_; c = c_; }
    __device__ bool next(int i, Unit& u) const {
        const long L = (long)i * G + c; u.z = 0; if (L >= nwg) return false;
        int wgid = (int)L; { const int q = nwg / NXCD, r = nwg % NXCD, xcd = wgid % NXCD, off = wgid / NXCD; wgid = (xcd < r ? xcd * (q + 1) : r * (q + 1) + (xcd - r) * q) + off; }
        const int nig = WGM * nN, gid = wgid / nig, fm = gid * WGM, gsz = (nM - fm) < WGM ? (nM - fm) : WGM;
        u.pm = fm + ((wgid % nig) % gsz); u.pn = (wgid % nig) / gsz; return true;
    }
};
struct TailOrder {
    StaticOrder so; int c0;
    __device__ bool next(int i, Unit& u) const {
        const int full = so.nwg / so.G; StaticOrder t = so;
        if (i < full) return so.next(i, u);
        const int cc = so.c - c0; u.z = 0; if (cc < 0) return false;
        const int L = full * so.G + (i - full) * (so.G - c0) + cc; if (L >= so.nwg) return false;
        t.c = L; return t.next(0, u);
    }
};
struct CritOrder {
    int G, c;
    __device__ bool next(int i, Unit& u) const { const int L = i * G + c; u.z = 0; if (L >= 120) return false; const int p = L % 12; u.pn = L / 12; u.pm = (p < 8) ? 8 * p + 7 : 56 + p; return true; }
};
struct F8Order {
    StaticOrder so; int c0;
    static constexpr int N1 = 68 * 32, N2 = 56 * 10, NT = N1 + N2;
    __device__ bool next(int i, Unit& u) const {
        const int full = NT / so.G; int L; u.z = 0;
        if (i < full) L = i * so.G + so.c;
        else { const int cc = so.c - c0; if (cc < 0) return false; L = full * so.G + (i - full) * (so.G - c0) + cc; }
        if (L >= NT) return false;
        if (L < N1) { StaticOrder t = so; t.c = L; return t.next(0, u); }
        int l2 = L - N1; if ((so.G & 7) == 0) l2 = (l2 & 7) * (N2 / 8) + (l2 >> 3);
        const int grp = l2 / 80, r = l2 % 80, pmq = grp * 8 + (r & 7);
        u.pn = 32 + (r >> 3); u.pm = (pmq / 7) * 8 + pmq % 7; return true;
    }
};
struct PairOrder {
    StaticOrder so;
    __device__ bool next(int i, Unit& u) const { const bool ok = so.next(i >> 1, u); u.z = i & 1; return ok; }
};

template <class Epi, class Sched, bool F8 = false>
__device__ __forceinline__ void gemm_phase(LAS unsigned char* lds, const Gemm g, const Sched& S, const Epi& E) {
    const int tid = threadIdx.x, wid = __builtin_amdgcn_readfirstlane(tid >> 6), lane = tid & 63, wr = wid >> 2, wc = wid & 3, fr = lane & 15, fq = lane >> 4;
    const int K = g.ld, nt = g.K / BK;
    unsigned voffA[2], voffB[2];
#pragma unroll
    for (int i = 0; i < 2; ++i) { int R, C; stage_rc(tid * 16 + i * 8192, R, C); const int Rb = Epi::PERM ? ((R & ~31) + perm32(R & 31)) : R;
        voffA[i] = (unsigned)(R * K + C) * 2u; voffB[i] = (unsigned)(Rb * K + C) * 2u; }
    const size_t kstep = (size_t)(BK * 2);
    const size_t hstep = (size_t)HALF * K * 2;
    const size_t tstep = 2 * hstep;
    const unsigned ldsw = (unsigned)wid * 1024u;
    const int aoff = lds_byte(wr * 64 + fr, fq * 8), boff = lds_byte(wc * 32 + fr, fq * 8);
#define PG8_SA(b, h) (((b) * 2 + (h)) * HTB)
#define PG8_SB(b, h) ((4 + (b) * 2 + (h)) * HTB)
#define PG8_STAGE(bufoff, gbase, voff) do { _Pragma("unroll") for (int _i = 0; _i < 2; ++_i) \
        __builtin_amdgcn_global_load_lds((const unsigned*)((const char*)(gbase) + (voff)[_i]), (LAS unsigned*)(lds + (bufoff) + ldsw + _i * 8192), 16, 0, 0); } while (0)
#define PG8_LDA(dst, b, h) do { if constexpr (F8) { _Pragma("unroll") for (int m = 0; m < 4; ++m) { const i32x4 lo_ = *(const LAS i32x4*)(lds + PG8_SA(b, h) + aoff + m * 2048), hi_ = *(const LAS i32x4*)(lds + PG8_SA(b, h) + aoff + m * 2048 + 1024); \
            dst##8[m] = __builtin_shufflevector(lo_, hi_, 0, 1, 2, 3, 4, 5, 6, 7); } } else { \
        _Pragma("unroll") for (int m = 0; m < 4; ++m) _Pragma("unroll") for (int k = 0; k < 2; ++k) dst[m][k] = *(const LAS bf16x8*)(lds + PG8_SA(b, h) + aoff + m * 2048 + k * 1024); } } while (0)
#define PG8_LDB(dst, b, h) do { if constexpr (F8) { _Pragma("unroll") for (int n = 0; n < 2; ++n) { const i32x4 lo_ = *(const LAS i32x4*)(lds + PG8_SB(b, h) + boff + n * 2048), hi_ = *(const LAS i32x4*)(lds + PG8_SB(b, h) + boff + n * 2048 + 1024); \
            dst##8[n] = __builtin_shufflevector(lo_, hi_, 0, 1, 2, 3, 4, 5, 6, 7); } } else { \
        _Pragma("unroll") for (int n = 0; n < 2; ++n) _Pragma("unroll") for (int k = 0; k < 2; ++k) dst[n][k] = *(const LAS bf16x8*)(lds + PG8_SB(b, h) + boff + n * 2048 + k * 1024); } } while (0)
#define PG8_MMA(ai, bj, At, Bt) do { __builtin_amdgcn_s_setprio(1); if constexpr (F8) { _Pragma("unroll") for (int m = 0; m < 4; ++m) _Pragma("unroll") for (int n = 0; n < 2; ++n) \
        asm volatile("v_mfma_f32_16x16x128_f8f6f4 %0, %1, %2, %0" : "+v"(acc[ai][bj][m][n]) : "v"(Bt##8[n]), "v"(At##8[m])); } else { \
        _Pragma("unroll") for (int m = 0; m < 4; ++m) _Pragma("unroll") for (int n = 0; n < 2; ++n) _Pragma("unroll") for (int k = 0; k < 2; ++k) \
        acc[ai][bj][m][n] = __builtin_amdgcn_mfma_f32_16x16x32_bf16(Bt[n][k], At[m][k], acc[ai][bj][m][n], 0, 0, 0); } __builtin_amdgcn_s_setprio(0); } while (0)
#define PG8_WAIT_V(n) asm volatile("s_waitcnt vmcnt(" #n ")" ::: "memory")
#define PG8_WAIT_L(n) asm volatile("s_waitcnt lgkmcnt(" #n ")" ::: "memory")
#define PG8_BAR __builtin_amdgcn_s_barrier()
#define PG8_SCHED __builtin_amdgcn_sched_barrier(0)
    Unit cur, nxt; int ui = 0;
    if (!S.next(0, cur)) return;
    f32x4 acc[2][2][4][2];
#pragma unroll
    for (int a = 0; a < 2; ++a)
#pragma unroll
        for (int b = 0; b < 2; ++b)
#pragma unroll
            for (int m = 0; m < 4; ++m)
#pragma unroll
                for (int n = 0; n < 2; ++n) acc[a][b][m][n] = (f32x4){0.f, 0.f, 0.f, 0.f};
    bf16x8 At[4][2], B0[2][2], B1[2][2]; i32x8 At8[4], B08[2], B18[2];
    const char* cA = (const char*)g.A + (size_t)cur.z * g.zA + (size_t)cur.pm * tstep; const char* cB = (const char*)g.Bt + (size_t)cur.z * g.zB + (size_t)cur.pn * tstep;
    PG8_STAGE(PG8_SB(0, 0), cB, voffB); PG8_STAGE(PG8_SB(0, 1), cB + hstep, voffB); PG8_STAGE(PG8_SA(0, 0), cA, voffA); PG8_STAGE(PG8_SA(0, 1), cA + hstep, voffA);
    if (wr == 1) PG8_BAR;
    PG8_WAIT_V(2); PG8_BAR;
    PG8_STAGE(PG8_SB(1, 0), cB + kstep, voffB); PG8_STAGE(PG8_SA(1, 0), cA + kstep, voffA); PG8_STAGE(PG8_SB(1, 1), cB + hstep + kstep, voffB);
    PG8_WAIT_V(6); PG8_BAR;
    for (;;) {
        const bool has_next = S.next(ui + 1, nxt);
        const char* nA = has_next ? (const char*)g.A + (size_t)nxt.z * g.zA + (size_t)nxt.pm * tstep : cA; const char* nB = has_next ? (const char*)g.Bt + (size_t)nxt.z * g.zB + (size_t)nxt.pn * tstep : cB;
        for (int t = 0; t < nt; t += 2) {
            const bool last = (t == nt - 2);
            const char* a1 = cA + (size_t)(t + 1) * kstep;
            const char* a2 = last ? nA : cA + (size_t)(t + 2) * kstep; const char* b2 = last ? nB : cB + (size_t)(t + 2) * kstep;
            const char* a3 = a2 + kstep; const char* b3 = b2 + kstep;
            PG8_LDB(B0, 0, 0); PG8_LDB(B1, 0, 1); PG8_SCHED; PG8_LDA(At, 0, 0); PG8_STAGE(PG8_SA(1, 1), a1 + hstep, voffA);
            PG8_WAIT_V(8); PG8_WAIT_L(0); PG8_BAR; PG8_MMA(0, 0, At, B0); PG8_MMA(0, 1, At, B1); PG8_BAR; PG8_SCHED;
            PG8_LDA(At, 0, 1); PG8_STAGE(PG8_SB(0, 0), b2, voffB); PG8_STAGE(PG8_SB(0, 1), b2 + hstep, voffB); PG8_STAGE(PG8_SA(0, 0), a2, voffA);
            PG8_WAIT_V(8); PG8_WAIT_L(0); PG8_BAR; PG8_MMA(1, 0, At, B0); PG8_MMA(1, 1, At, B1); PG8_BAR; PG8_SCHED;
            PG8_LDB(B0, 1, 0); PG8_LDB(B1, 1, 1); PG8_SCHED; PG8_LDA(At, 1, 0); PG8_STAGE(PG8_SA(0, 1), a2 + hstep, voffA);
            PG8_WAIT_V(8); PG8_WAIT_L(0); PG8_BAR; PG8_MMA(0, 0, At, B0); PG8_MMA(0, 1, At, B1); PG8_BAR; PG8_SCHED;
            PG8_LDA(At, 1, 1); PG8_STAGE(PG8_SB(1, 0), b3, voffB); PG8_STAGE(PG8_SB(1, 1), b3 + hstep, voffB); PG8_STAGE(PG8_SA(1, 0), a3, voffA);
            PG8_WAIT_V(8); PG8_WAIT_L(0); PG8_BAR; PG8_MMA(1, 0, At, B0); PG8_MMA(1, 1, At, B1); PG8_BAR; PG8_SCHED;
        }
        if (wr == 0) PG8_BAR;
        if constexpr (F8) asm volatile("s_nop 15\n\ts_nop 15" ::: "memory");
        E(acc, cur, wr, wc, fr, fq);
        if (!has_next) break;
        if (!(Epi::MID && cur.z == 0)) {
#pragma unroll
        for (int a = 0; a < 2; ++a)
#pragma unroll
            for (int b = 0; b < 2; ++b)
#pragma unroll
                for (int m = 0; m < 4; ++m)
#pragma unroll
                    for (int n = 0; n < 2; ++n) acc[a][b][m][n] = (f32x4){0.f, 0.f, 0.f, 0.f};
        }
        cur = nxt; cA = nA; cB = nB; ++ui;
        if (wr == 1) PG8_BAR;
    }
    PG8_WAIT_V(0);
    PG8_BAR;
#undef PG8_SA
#undef PG8_SB
#undef PG8_STAGE
#undef PG8_LDA
#undef PG8_LDB
#undef PG8_MMA
#undef PG8_WAIT_V
#undef PG8_WAIT_L
#undef PG8_BAR
#undef PG8_SCHED
}
}

struct Epi1b {
    static constexpr bool MID = false;
    static constexpr bool PERM = true;
    bf16_t *U, *Kb, *Vb; float* out;
    __device__ __forceinline__ void operator()(const f32x4 (&acc)[2][2][4][2], const pg8::Unit& u, int wr, int wc, int fr, int fq) const {
        const int row0 = u.pm * 256 + wr * 64 + fr, pn = u.pn;
        if (pn < 8) {
#pragma unroll
            for (int ai = 0; ai < 2; ++ai)
#pragma unroll
                for (int m = 0; m < 4; ++m) {
                    const int row = row0 + ai * 128 + m * 16;
#pragma unroll
                    for (int bj = 0; bj < 2; ++bj) {
                        const int ch = pn * 128 + bj * 64 + wc * 16 + fq * 4;
                        const f32x4 uu = acc[ai][bj][m][0] * acc[ai][bj][m][1];
                        u32x2 wu_; wu_.x = cvt_pk_bf16(uu[0], uu[1]); wu_.y = cvt_pk_bf16(uu[2], uu[3]);
                        *(u32x2*)(U + (size_t)row * 1024 + ch) = wu_;
                        if (row < MP) { const int t = row & (SEQ - 1); if (t >= SEQ - 2) *(f32x4*)(out + O_CP + (size_t)((row >> 11) * 2 + (t - (SEQ - 2))) * 1024 + ch) = uu; }
                        else { const int r2 = row - MP, i = r2 & 7; if (i >= 6) *(f32x4*)(out + O_CS + (size_t)((r2 >> 3) * 2 + (i - 6)) * 1024 + ch) = uu; }
                    }
                }
        } else {
            bf16_t* dst = (pn == 8) ? Kb : Vb;
            const size_t op = (pn == 8) ? O_KP : O_VP, os = (pn == 8) ? O_KS : O_VS;
            const int col0 = wc * 32 + 8 * fq;
#pragma unroll
            for (int ai = 0; ai < 2; ++ai)
#pragma unroll
                for (int m = 0; m < 4; ++m) {
                    const int row = row0 + ai * 128 + m * 16; float* dp = nullptr;
                    if (row < MP) { const int t = row & (SEQ - 1); if (t >= SEQ - 128) dp = out + op + (size_t)((row >> 11) * 128 + (t - (SEQ - 128))) * 256; }
                    else { const int r2 = row - MP; dp = out + os + (size_t)((r2 >> 3) * 128 + 120 + (r2 & 7)) * 256; }
#pragma unroll
                    for (int bj = 0; bj < 2; ++bj) {
                        const f32x4 v0 = acc[ai][bj][m][0], v1 = acc[ai][bj][m][1];
                        u32x4 w; w.x = cvt_pk_bf16(v0[0], v0[1]); w.y = cvt_pk_bf16(v0[2], v0[3]); w.z = cvt_pk_bf16(v1[0], v1[1]); w.w = cvt_pk_bf16(v1[2], v1[3]);
                        *(u32x4*)(dst + (size_t)row * 256 + col0 + bj * 128) = w;
                        if (dp) { float* p = dp + bj * 128 + col0; *(f32x4*)p = v0; *(f32x4*)(p + 4) = v1; }
                    }
                }
        }
    }
};
struct Epi1f {
    static constexpr bool MID = false;
    static constexpr bool PERM = true;
    unsigned char* ws; bf16_t* S;
    __device__ __forceinline__ void operator()(const f32x4 (&acc)[2][2][4][2], const pg8::Unit& u, int wr, int wc, int fr, int fq) const {
        const int row0 = u.pm * 256 + wr * 64 + fr, pn = u.pn;
        constexpr float US = 1.0f / (XSC * WSC);
        if (pn < 8) {
#pragma unroll
            for (int ai = 0; ai < 2; ++ai)
#pragma unroll
                for (int m = 0; m < 4; ++m) {
                    const int row = row0 + ai * 128 + m * 16;
#pragma unroll
                    for (int bj = 0; bj < 2; ++bj) {
                        const int ch = pn * 128 + bj * 64 + wc * 16 + fq * 4;
                        const f32x4 gz = acc[ai][bj][m][0] * acc[ai][bj][m][1] * (US * US); f32x4 sv;
#pragma unroll
                        for (int e = 0; e < 4; ++e) sv[e] = gz[e] * __builtin_amdgcn_rcpf(1.0f + __builtin_amdgcn_exp2f(acc[ai][bj][m][1][e] * (-US * LOG2E)));
                        u32x2 w_; w_.x = cvt_pk_bf16(sv[0], sv[1]); w_.y = cvt_pk_bf16(sv[2], sv[3]);
                        *(u32x2*)(S + (size_t)row * 1024 + ch) = w_;
                    }
                }
        } else {
            if (pn >= 32) {
                if (pn < 40) {
#pragma unroll
                    for (int ai = 0; ai < 2; ++ai)
#pragma unroll
                        for (int m = 0; m < 4; ++m) {
                            const int row = row0 + ai * 128 + m * 16;
#pragma unroll
                            for (int bj = 0; bj < 2; ++bj) {
                                const int ch = (pn - 32) * 128 + bj * 64 + wc * 16 + fq * 4;
                                const f32x4 uu = acc[ai][bj][m][0] * acc[ai][bj][m][1] * (US * US);
                                u32x2 wu_; wu_.x = cvt_pk_bf16(uu[0], uu[1]); wu_.y = cvt_pk_bf16(uu[2], uu[3]);
                                *(u32x2*)((bf16_t*)(ws + W_U) + (size_t)row * 1024 + ch) = wu_;
                            }
                        }
                } else {
                    bf16_t* dst = (bf16_t*)(ws + (pn == 40 ? W_K : W_V));
#pragma unroll
                    for (int ai = 0; ai < 2; ++ai)
#pragma unroll
                        for (int m = 0; m < 4; ++m) {
                            bf16_t* rowp = dst + (size_t)(row0 + ai * 128 + m * 16) * 256 + wc * 32 + 8 * fq;
#pragma unroll
                            for (int bj = 0; bj < 2; ++bj) {
                                const f32x4 v0 = acc[ai][bj][m][0] * US, v1 = acc[ai][bj][m][1] * US;
                                u32x4 w; w.x = cvt_pk_bf16(v0[0], v0[1]); w.y = cvt_pk_bf16(v0[2], v0[3]); w.z = cvt_pk_bf16(v1[0], v1[1]); w.w = cvt_pk_bf16(v1[2], v1[3]);
                                *(u32x4*)(rowp + bj * 128) = w;
                            }
                        }
                }
                return;
            }
            if (pn >= 16) {
#pragma unroll
                for (int ai = 0; ai < 2; ++ai)
#pragma unroll
                    for (int m = 0; m < 4; ++m) {
                        const int row = row0 + ai * 128 + m * 16;
#pragma unroll
                        for (int bj = 0; bj < 2; ++bj) {
                            const int col = (pn - 16) * 128 + bj * 64 + wc * 16 + fq * 4;
                            f32x4 rr, sa;
#pragma unroll
                            for (int e = 0; e < 4; ++e) {
                                const float ec = __builtin_amdgcn_exp2f(acc[ai][bj][m][0][e] * (-US * LOG2E)), ea = fminf(__builtin_amdgcn_exp2f(acc[ai][bj][m][1][e] * (-US * LOG2E)), 1.152921504606847e18f);
                                sa[e] = __builtin_amdgcn_rcpf(1.0f + ea); rr[e] = ((YASC / YCSC) + (YASC / YCSC) * ea) * __builtin_amdgcn_rcpf(1.0f + ec);
                            }
                            u32x2 w1, w2; w1.x = cvt_pk_bf16(rr[0], rr[1]); w1.y = cvt_pk_bf16(rr[2], rr[3]); w2.x = cvt_pk_bf16(sa[0], sa[1]); w2.y = cvt_pk_bf16(sa[2], sa[3]);
                            *(u32x2*)((bf16_t*)(ws + W_GC) + (size_t)row * 2048 + col) = w1; *(u32x2*)((bf16_t*)(ws + W_GA) + (size_t)row * 2048 + col) = w2;
                        }
                    }
                return;
            }
            unsigned long long doff; int ld, colt, act; float scale = US;
            if (pn < 12) { doff = W_Q; ld = 1024; colt = (pn - 8) * 256; act = 0; scale = QSCALE * US; }
            else { doff = W_ZA; ld = 1024; colt = (pn - 12) * 256; act = 1; }
            bf16_t* dst = (bf16_t*)(ws + doff);
            const int col0 = colt + wc * 32 + 8 * fq;
#pragma unroll
            for (int ai = 0; ai < 2; ++ai)
#pragma unroll
                for (int m = 0; m < 4; ++m) {
                    bf16_t* rowp = dst + (size_t)(row0 + ai * 128 + m * 16) * ld + col0;
#pragma unroll
                    for (int bj = 0; bj < 2; ++bj) {
                        float v[8];
#pragma unroll
                        for (int e = 0; e < 4; ++e) { v[e] = acc[ai][bj][m][0][e] * scale; v[4 + e] = acc[ai][bj][m][1][e] * scale; }
                        if (act != 0) {
#pragma unroll
                            for (int e = 0; e < 4; ++e) { v[e] *= __builtin_amdgcn_rcpf(1.0f + __builtin_amdgcn_exp2f(acc[ai][bj][m][0][e] * (-US * LOG2E))); v[4 + e] *= __builtin_amdgcn_rcpf(1.0f + __builtin_amdgcn_exp2f(acc[ai][bj][m][1][e] * (-US * LOG2E))); }
                        }
                        u32x4 w; w.x = cvt_pk_bf16(v[0], v[1]); w.y = cvt_pk_bf16(v[2], v[3]); w.z = cvt_pk_bf16(v[4], v[5]); w.w = cvt_pk_bf16(v[6], v[7]);
                        *(u32x4*)(rowp + bj * 128) = w;
                    }
                }
        }
    }
};
struct Epi2 {
    static constexpr bool PERM = true, MID = true;
    const bf16_t *R, *SA; unsigned char* MG;
    __device__ __forceinline__ void mid(f32x4 (&acc)[2][2][4][2], const pg8::Unit& u, int wr, int wc, int fr, int fq) const {
        const int row0 = u.pm * 256 + wr * 64 + fr, col0 = u.pn * 256 + wc * 32 + 8 * fq;
#pragma unroll
        for (int ai = 0; ai < 2; ++ai)
#pragma unroll
            for (int m = 0; m < 4; ++m) {
                const size_t ro = (size_t)(row0 + ai * 128 + m * 16) * 2048 + col0;
#pragma unroll
                for (int bj = 0; bj < 2; ++bj) {
                    const u32x4 gw = *(const u32x4*)(R + ro + bj * 128);
                    acc[ai][bj][m][0][0] *= bf_lo(gw.x); acc[ai][bj][m][0][1] *= bf_hi(gw.x); acc[ai][bj][m][0][2] *= bf_lo(gw.y); acc[ai][bj][m][0][3] *= bf_hi(gw.y);
                    acc[ai][bj][m][1][0] *= bf_lo(gw.z); acc[ai][bj][m][1][1] *= bf_hi(gw.z); acc[ai][bj][m][1][2] *= bf_lo(gw.w); acc[ai][bj][m][1][3] *= bf_hi(gw.w);
                }
            }
    }
    __device__ __forceinline__ void operator()(f32x4 (&acc)[2][2][4][2], const pg8::Unit& u, int wr, int wc, int fr, int fq) const {
        if (u.z == 0) { mid(acc, u, wr, wc, fr, fq); return; }
        const int row0 = u.pm * 256 + wr * 64 + fr, col0 = u.pn * 256 + wc * 32 + 8 * fq;
        constexpr float us = MSC / (YASC * WSC);
#pragma unroll
        for (int ai = 0; ai < 2; ++ai) {
            u32x4 gws[4][2];
#pragma unroll
            for (int m = 0; m < 4; ++m)
#pragma unroll
                for (int bj = 0; bj < 2; ++bj) gws[m][bj] = *(const u32x4*)(SA + (size_t)(row0 + ai * 128 + m * 16) * 2048 + col0 + bj * 128);
#pragma unroll
            for (int m = 0; m < 4; ++m) {
                const size_t ro = (size_t)(row0 + ai * 128 + m * 16) * 2048 + col0;
#pragma unroll
                for (int bj = 0; bj < 2; ++bj) {
                    const u32x4 gw = gws[m][bj];
                    f32x4 v0 = acc[ai][bj][m][0] * us, v1 = acc[ai][bj][m][1] * us;
                    v0[0] *= bf_lo(gw.x); v0[1] *= bf_hi(gw.x); v0[2] *= bf_lo(gw.y); v0[3] *= bf_hi(gw.y);
                    v1[0] *= bf_lo(gw.z); v1[1] *= bf_hi(gw.z); v1[2] *= bf_lo(gw.w); v1[3] *= bf_hi(gw.w);
                    u32x2 w; w.x = pk4_fp8(v0[0], v0[1], v0[2], v0[3]); w.y = pk4_fp8(v1[0], v1[1], v1[2], v1[3]);
                    *(u32x2*)(MG + ro + bj * 128) = w;
                }
            }
        }
    }
};
struct Epi3 {
    static constexpr bool PERM = true, MID = false;
    bf16_t* OB;
    __device__ __forceinline__ void operator()(const f32x4 (&acc)[2][2][4][2], const pg8::Unit& u, int wr, int wc, int fr, int fq) const {
        const int row0 = u.pm * 256 + wr * 64 + fr, col0 = u.pn * 256 + wc * 32 + 8 * fq;
        constexpr float us = 1.0f / (WSC * MSC);
#pragma unroll
        for (int ai = 0; ai < 2; ++ai)
#pragma unroll
            for (int m = 0; m < 4; ++m) {
                bf16_t* rowp = OB + (size_t)(row0 + ai * 128 + m * 16) * DM + col0;
#pragma unroll
                for (int bj = 0; bj < 2; ++bj) {
                    const f32x4 v0 = acc[ai][bj][m][0] * us, v1 = acc[ai][bj][m][1] * us;
                    u32x4 w; w.x = cvt_pk_bf16(v0[0], v0[1]); w.y = cvt_pk_bf16(v0[2], v0[3]); w.z = cvt_pk_bf16(v1[0], v1[1]); w.w = cvt_pk_bf16(v1[2], v1[3]);
                    *(u32x4*)(rowp + bj * 128) = w;
                }
            }
    }
};

__device__ __forceinline__ int pair_row(int chn, int n) { const int pn = chn >> 7, cl = chn & 127, bj = cl >> 6, wc = (cl >> 4) & 3, fq = (cl >> 2) & 3, e = cl & 3; return pn * 256 + bj * 128 + wc * 32 + fq * 8 + n * 4 + e; }
__device__ __forceinline__ int map_w1(int nsrc, bool& f8) {
    if (nsrc < 1024) { f8 = true; return pair_row(nsrc, 0); }
    if (nsrc < 2048) { f8 = false; return pair_row(nsrc - 1024, 0); }
    if (nsrc < 3072) { f8 = false; return pair_row(nsrc - 2048, 1); }
    if (nsrc < 4096) { f8 = true; return pair_row(nsrc - 3072, 1); }
    if (nsrc < 5120) { f8 = true; return 2048 + (nsrc - 4096); }
    if (nsrc < 5376) { f8 = false; return 2048 + (nsrc - 5120); }
    if (nsrc < 5632) { f8 = false; return 2304 + (nsrc - 5376); }
    if (nsrc < 6656) { f8 = true; return 3072 + (nsrc - 5632); }
    if (nsrc < 8704) { f8 = true; return 4096 + pair_row(nsrc - 6656, 0); }
    f8 = true; return 4096 + pair_row(nsrc - 8704, 1);
}
template <int MODE>
__device__ __forceinline__ void transpose_item(const float* __restrict__ W, int K, int N, bf16_t* __restrict__ WTb, unsigned char* __restrict__ WT8, int ldk, int koff, LAS float* scr, int item, int lane) {
    const int nblk = N / 32, kb = item / nblk, nb = item % nblk, k0 = 64 * kb, n0 = 32 * nb;
    const int c = lane & 7;
    {   f32x4 v[8];
#pragma unroll
        for (int i = 0; i < 8; ++i) v[i] = __builtin_nontemporal_load((const f32x4*)(W + (size_t)(k0 + 8 * i + (lane >> 3)) * N + n0 + 4 * c));
#pragma unroll
        for (int i = 0; i < 8; ++i) { LAS float* d = scr + (8 * i + (lane >> 3)) * 33 + 4 * c; d[0] = v[i][0]; d[1] = v[i][1]; d[2] = v[i][2]; d[3] = v[i][3]; }
    }
    asm volatile("s_waitcnt lgkmcnt(0)" ::: "memory");
#pragma unroll
    for (int j = 0; j < 4; ++j) { const int n = (lane >> 3) + 8 * j; const LAS float* sp = scr + (8 * c) * 33 + n;
        bool f8 = true; const int drow = (MODE == 1) ? map_w1(n0 + n, f8) : (n0 + n);
        if (f8) { u32x2 o; o.x = pk4_fp8(sp[0 * 33] * WSC, sp[1 * 33] * WSC, sp[2 * 33] * WSC, sp[3 * 33] * WSC); o.y = pk4_fp8(sp[4 * 33] * WSC, sp[5 * 33] * WSC, sp[6 * 33] * WSC, sp[7 * 33] * WSC);
            *(u32x2*)(WT8 + (size_t)drow * ldk + koff + k0 + 8 * c) = o; }
        else { u32x4 o; o.x = cvt_pk_bf16(sp[0 * 33], sp[1 * 33]); o.y = cvt_pk_bf16(sp[2 * 33], sp[3 * 33]); o.z = cvt_pk_bf16(sp[4 * 33], sp[5 * 33]); o.w = cvt_pk_bf16(sp[6 * 33], sp[7 * 33]);
            *(u32x4*)(WTb + (size_t)drow * ldk + koff + k0 + 8 * c) = o;
            u32x2 o8; o8.x = pk4_fp8(sp[0 * 33] * WSC, sp[1 * 33] * WSC, sp[2 * 33] * WSC, sp[3 * 33] * WSC); o8.y = pk4_fp8(sp[4 * 33] * WSC, sp[5 * 33] * WSC, sp[6 * 33] * WSC, sp[7 * 33] * WSC);
            *(u32x2*)(WT8 + (size_t)(NF8 + drow) * ldk + koff + k0 + 8 * c) = o8; } }
    asm volatile("s_waitcnt lgkmcnt(0)" ::: "memory");
}

__device__ __forceinline__ int crow(int r, int hi) { return (r & 3) + 8 * (r >> 2) + 4 * hi; }
template <bool SAMPLE>
__device__ __forceinline__ void attn_sub(const bf16_t* __restrict__ Qb, const bf16_t* __restrict__ ZA, unsigned char* __restrict__ YA, const float* __restrict__ sinks,
                                         LAS const unsigned char* kbase, int krow0, LAS const unsigned char* vbase, int vrowb, int vcol0,
                                         int rowbase, int headbase, int i0, bool firstblk, int lane, LAS unsigned char* oscr) {
    const int q = lane & 31, hi = lane >> 5;
    const int head = SAMPLE ? headbase + (q >> 3) : headbase;
    const int qi = SAMPLE ? (q & 7) : i0 + q;
    const size_t qoff = SAMPLE ? (size_t)(rowbase + (q & 7)) * 1024 + head * 64 : (size_t)(rowbase + q) * 1024 + head * 64;
    const float sl2 = __builtin_amdgcn_exp2f(-0.5f * (float)(head + 1)) * LOG2E;
    const float sink2 = sinks[head] * LOG2E;
    bf16x8 qf[4];
#pragma unroll
    for (int ks = 0; ks < 4; ++ks) qf[ks] = *(const bf16x8*)(Qb + qoff + ks * 16 + hi * 8);
    const int qrel = SAMPLE ? (q & 7) : q, th = qrel - 4 * hi;
    const float nb = -sl2 * (float)(128 + th);
    f32x16 s[5];
#pragma unroll
    for (int T = 0; T < 5; ++T) {
#pragma unroll
        for (int r = 0; r < 16; ++r) s[T][r] = sl2 * (float)(32 * T + (r & 3) + 8 * (r >> 2)) + nb;
        const int krow = krow0 + 32 * T + q;
        LAS const unsigned char* kp = kbase + krow * 128;
#pragma unroll
        for (int ks = 0; ks < 4; ++ks) {
            const bf16x8 kf = *(LAS const bf16x8*)(kp + (((2 * ks + hi) ^ (krow & 7)) * 16));
            s[T] = __builtin_amdgcn_mfma_f32_32x32x16_bf16(kf, qf[ks], s[T], 0, 0, 0);
        }
    }
    float mx = sink2;
#pragma unroll
    for (int T = 0; T < 5; ++T) {
        const bool dead = firstblk && (i0 + 32 * T < 128);
#pragma unroll
        for (int r = 0; r < 16; ++r) {
            const int cr = (r & 3) + 8 * (r >> 2);
            bool valid = !dead;
            if (T == 0) valid = valid && (cr >= th);
            if (T == 4) valid = valid && (cr <= th);
            const float v = valid ? s[T][r] : -1e30f;
            s[T][r] = v; mx = fmaxf(mx, v);
        }
        __builtin_amdgcn_sched_barrier(0);
    }
    mx = fmaxf(mx, __shfl_xor(mx, 32));
    float sum = 0.f;
#pragma unroll
    for (int T = 0; T < 5; ++T)
#pragma unroll
        for (int r = 0; r < 16; ++r) { const float p = __builtin_amdgcn_exp2f(s[T][r] - mx); s[T][r] = p; sum += p; }
    sum += __shfl_xor(sum, 32);
    const float inv = __builtin_amdgcn_rcpf(sum + __builtin_amdgcn_exp2f(sink2 - mx));
    f32x16 o[2];
#pragma unroll
    for (int r = 0; r < 16; ++r) { o[0][r] = 0.f; o[1][r] = 0.f; }
#pragma unroll
    for (int T = 0; T < 5; ++T)
#pragma unroll
        for (int st = 0; st < 2; ++st) {
            u32x4 pw;
            pw.x = cvt_pk_bf16(s[T][8 * st + 0] * inv, s[T][8 * st + 1] * inv); pw.y = cvt_pk_bf16(s[T][8 * st + 2] * inv, s[T][8 * st + 3] * inv);
            pw.z = cvt_pk_bf16(s[T][8 * st + 4] * inv, s[T][8 * st + 5] * inv); pw.w = cvt_pk_bf16(s[T][8 * st + 6] * inv, s[T][8 * st + 7] * inv);
            const bf16x8 pf = __builtin_bit_cast(bf16x8, pw);
#pragma unroll
            for (int dt = 0; dt < 2; ++dt) {
                LAS const unsigned char* vp = vbase + (32 * dt + q) * vrowb + (vcol0 + 32 * T + 16 * st + 4 * hi) * 2;
                const s16x4 lo = *(LAS const s16x4*)vp, h4 = *(LAS const s16x4*)(vp + 16);
                const bf16x8 vf = (bf16x8){lo[0], lo[1], lo[2], lo[3], h4[0], h4[1], h4[2], h4[3]};
                o[dt] = __builtin_amdgcn_mfma_f32_32x32x16_bf16(pf, vf, o[dt], 0, 0, 0);
            }
        }
    {
        LAS float* osc = (LAS float*)oscr;
#pragma unroll
        for (int r = 0; r < 16; ++r) { const int qq = crow(r, hi); osc[qq * 68 + q] = o[0][r]; osc[qq * 68 + 32 + q] = o[1][r]; }
        asm volatile("s_waitcnt lgkmcnt(0)" ::: "memory");
        const int rq = lane >> 1, hf = lane & 1;
        const size_t orow = SAMPLE ? (size_t)(rowbase + (rq & 7)) : (size_t)(rowbase + rq);
        const size_t ocol = (SAMPLE ? (size_t)(headbase + (rq >> 3)) * 64 : (size_t)headbase * 64) + (size_t)hf * 32;
        const u32x4* zp = (const u32x4*)(ZA + orow * 1024 + ocol);
        u32x4 zw[4];
#pragma unroll
        for (int k = 0; k < 4; ++k) zw[k] = zp[k];
        unsigned w8[8];
#pragma unroll
        for (int k = 0; k < 8; ++k) {
            const f32x4 ov = *(LAS const f32x4*)(osc + rq * 68 + hf * 32 + 4 * k);
            const unsigned ga = zw[k >> 1][(k & 1) * 2], gb2 = zw[k >> 1][(k & 1) * 2 + 1];
            w8[k] = pk4_fp8(ov[0] * bf_lo(ga) * YASC, ov[1] * bf_hi(ga) * YASC, ov[2] * bf_lo(gb2) * YASC, ov[3] * bf_hi(gb2) * YASC);
        }
        u32x4* yp = (u32x4*)(YA + orow * 2048 + ocol);
        yp[0] = (u32x4){w8[0], w8[1], w8[2], w8[3]}; yp[1] = (u32x4){w8[4], w8[5], w8[6], w8[7]};
        asm volatile("s_waitcnt lgkmcnt(0)" ::: "memory");
    }
}

#define XB_TMO      128
#define XB_XCNT(j)  (256  + 64 * (j))
#define XB_XSUB(j)  (1280 + 64 * (j))
#define XB_XGEN(j)  (2304 + 64 * (j))
#define XB_TOP      3328
#define XB_TOPGEN   3392
#define XCD_BAR_WORDS 3456
#define XB_SPIN_CAP (1u << 18)
__device__ __forceinline__ unsigned xb_ld(unsigned* p)              { return __hip_atomic_load(p, __ATOMIC_RELAXED, __HIP_MEMORY_SCOPE_AGENT); }
__device__ __forceinline__ unsigned xb_add(unsigned* p, unsigned v) { return __hip_atomic_fetch_add(p, v, __ATOMIC_RELAXED, __HIP_MEMORY_SCOPE_AGENT); }
__device__ __forceinline__ unsigned xb_xcc_id() { return (unsigned)__builtin_amdgcn_s_getreg((3 << 11) | 20) & 0xFu; }
#define XB_SPIN(cond, bar) do { unsigned _sp = 0; while (cond) { __builtin_amdgcn_s_sleep(1); \
    if ((++_sp & 255u) == 0u) { if (xb_ld(&(bar)[XB_TMO])) break; if (_sp > XB_SPIN_CAP) { atomicAdd(&(bar)[XB_TMO], 1u); break; } } } } while (0)
struct XcdBarrier { unsigned* bar; unsigned x; volatile LAS unsigned* st; };
__device__ __forceinline__ XcdBarrier xcd_barrier_post(unsigned* bar, volatile LAS unsigned* st) {
    XcdBarrier b; b.bar = bar; b.x = xb_xcc_id(); b.st = st;
    if (threadIdx.x == 0) (void)xb_add(&bar[XB_XCNT(b.x)], 1u);
    return b;
}
__device__ __forceinline__ void xcd_barrier_complete(unsigned* bar, unsigned x, unsigned& nloc, unsigned& nx) {
    const unsigned G = gridDim.x * gridDim.y * gridDim.z;
    unsigned sum, cnt, mine, sp = 0u;
    for (;;) {
        sum = 0u; cnt = 0u; mine = 0u;
#pragma unroll
        for (unsigned j = 0; j < 16; ++j) { const unsigned c = xb_ld(&bar[XB_XCNT(j)]); sum += c; cnt += (c > 0u) ? 1u : 0u; mine = (j == x) ? c : mine; }
        if (sum == G) break;
        __builtin_amdgcn_s_sleep(1);
        if ((++sp & 255u) == 0u) { if (xb_ld(&bar[XB_TMO])) break; if (sp > XB_SPIN_CAP) { atomicAdd(&bar[XB_TMO], 1u); break; } }
    }
    nloc = mine > 0u ? mine : 1u; nx = cnt > 0u ? cnt : 1u;
}
__device__ __forceinline__ void xcd_barrier(const XcdBarrier& b) {
    asm volatile("s_waitcnt vmcnt(0)" ::: "memory");
    __syncthreads();
    if (threadIdx.x == 0) {
        unsigned* bar = b.bar;
        __builtin_amdgcn_s_waitcnt(0);
        unsigned nloc = b.st[0], nx = b.st[1];
        if (nloc == 0u) { xcd_barrier_complete(bar, b.x, nloc, nx); b.st[0] = nloc; b.st[1] = nx; }
        const unsigned old = xb_add(&bar[XB_XSUB(b.x)], 1u);
        const unsigned gen = old / nloc;
        if (old + 1u == (gen + 1u) * nloc) {
            __builtin_amdgcn_fence(__ATOMIC_RELEASE, "agent");
            asm volatile("s_waitcnt vmcnt(0)" ::: "memory");
            const unsigned og = xb_add(&bar[XB_TOP], 1u);
            const unsigned tg = og / nx;
            if (og + 1u == (tg + 1u) * nx) xb_add(&bar[XB_TOPGEN], 1u);
            else XB_SPIN(xb_ld(&bar[XB_TOPGEN]) == tg, bar);
            __builtin_amdgcn_fence(__ATOMIC_ACQUIRE, "agent");
            xb_add(&bar[XB_XGEN(b.x)], 1u);
            asm volatile("s_waitcnt vmcnt(0)" ::: "memory");
        } else {
            XB_SPIN(xb_ld(&bar[XB_XGEN(b.x)]) == gen, bar);
            __builtin_amdgcn_fence(__ATOMIC_ACQUIRE, "agent");
            asm volatile("s_waitcnt vmcnt(0)" ::: "memory");
        }
    }
    __syncthreads();
}

struct Args { const float* in[13]; float* out; unsigned char* ws; };

__global__ void __launch_bounds__(512, 2) hybrid_fwd(Args a) {
    extern __shared__ __attribute__((aligned(16))) unsigned char lds_raw[];
    LAS unsigned char* lds = (LAS unsigned char*)lds_raw;
    cg::grid_group grid = cg::this_grid();
    const int tid = threadIdx.x, lane = tid & 63, wave = __builtin_amdgcn_readfirstlane(tid >> 6);
    const int G = gridDim.x, c = blockIdx.x;
    unsigned char* ws = a.ws;
    bf16_t* W1B = (bf16_t*)(ws + W_W1B); unsigned char* W18 = ws + W_W18; unsigned char* W2T = ws + W_W2T; unsigned char* W3T = ws + W_W3T;
    bf16_t* XB = (bf16_t*)(ws + W_XB); unsigned char* MG = (unsigned char*)XB; unsigned char* X8 = ws + W_X8;
    bf16_t* Sb = (bf16_t*)(ws + W_S); bf16_t* Ub = (bf16_t*)(ws + W_U); bf16_t* Qb = (bf16_t*)(ws + W_Q); bf16_t* Kb = (bf16_t*)(ws + W_K); bf16_t* Vb = (bf16_t*)(ws + W_V);
    bf16_t* ZA = (bf16_t*)(ws + W_ZA); bf16_t* GC = (bf16_t*)(ws + W_GC); bf16_t* GA = (bf16_t*)(ws + W_GA);
    unsigned char* YC = ws + W_YCA; unsigned char* YA = YC + 1024;
    float* out = a.out;

    for (int i = tid; i < LDS_BYTES / 16; i += 512) ((LAS u32x4*)lds)[i] = (u32x4){0u, 0u, 0u, 0u};
    __syncthreads();
    (void)xcd_barrier_post((unsigned*)(ws + W_CTL), (volatile LAS unsigned*)(lds + LDS_BYTES - 64));
#define GRID_BAR() do { XcdBarrier xb_; xb_.bar = (unsigned*)(a.ws + W_CTL); xb_.x = xb_xcc_id(); xb_.st = (volatile LAS unsigned*)(lds + LDS_BYTES - 64); xcd_barrier(xb_); } while (0)

    {
        LAS float* scr = (LAS float*)(lds + wave * 16384);
        const int gw = c * 8 + wave, NGW = G * 8;
        constexpr int I1 = (DM / 64) * (NIN / 32), I2 = (1024 / 64) * (DM / 32), I3 = (DM / 64) * (DM / 32);
        const size_t n8 = (size_t)MT * DM / 8, n8p = (size_t)MP * DM / 8, stride = (size_t)G * 512;
        size_t i0 = (size_t)c * 512 + tid; int it = gw;
        for (;;) {
            const bool ht = it < I1 + 2 * I2 + I3;
            if (!ht && i0 >= n8) break;
            f32x4 v0[8], v1[8];
#pragma unroll
            for (int uu = 0; uu < 8; ++uu) { const size_t i = i0 + uu * stride;
                if (i < n8) { const float* src = (i < n8p) ? a.in[0] + i * 8 : a.in[1] + (i - n8p) * 8; v0[uu] = __builtin_nontemporal_load((const f32x4*)src); v1[uu] = __builtin_nontemporal_load((const f32x4*)(src + 4)); } }
            if (ht) {
                int r = it;
                if (r < I1) transpose_item<1>(a.in[5], DM, NIN, W1B, W18, DM, 0, scr, r, lane);
                else if ((r -= I1) < I2) transpose_item<0>(a.in[8], 1024, DM, nullptr, W2T, DM, 0, scr, r, lane);
                else if ((r -= I2) < I2) transpose_item<0>(a.in[9], 1024, DM, nullptr, W2T, DM, 1024, scr, r, lane);
                else transpose_item<0>(a.in[10], DM, DM, nullptr, W3T, DM, 0, scr, r - I2, lane);
                it += NGW;
            }
#pragma unroll
            for (int uu = 0; uu < 8; ++uu) { const size_t i = i0 + uu * stride;
                if (i < n8) {
                    u32x4 w; w.x = cvt_pk_bf16(v0[uu][0], v0[uu][1]); w.y = cvt_pk_bf16(v0[uu][2], v0[uu][3]); w.z = cvt_pk_bf16(v1[uu][0], v1[uu][1]); w.w = cvt_pk_bf16(v1[uu][2], v1[uu][3]);
                    { const int row = (int)(i >> 8); if (row >= MP || ((row >> 8) & 7) == 7) *(u32x4*)(XB + i * 8) = w; }
                    u32x2 w8; w8.x = pk4_fp8(v0[uu][0] * XSC, v0[uu][1] * XSC, v0[uu][2] * XSC, v0[uu][3] * XSC); w8.y = pk4_fp8(v1[uu][0] * XSC, v1[uu][1] * XSC, v1[uu][2] * XSC, v1[uu][3] * XSC);
                    *(u32x2*)(X8 + i * 8) = w8; } }
            i0 += 8 * stride;
        }
    }
    if (a.ws == nullptr) grid.sync();
    GRID_BAR();

    {
        {
            pg8::Gemm g{XB, W1B, MT, NB16, DM, 0, 0, DM}; pg8::CritOrder S{G, c};
            Epi1b E{Ub, Kb, Vb, out};
            pg8::gemm_phase<Epi1b, pg8::CritOrder, false>(lds, g, S, E);
        }
        {
            pg8::Gemm g{(const bf16_t*)X8, (const bf16_t*)W18, MT, NF8 + NB16, DM / 2, 0, 0, DM / 2}; pg8::F8Order S; S.so.init(MT, NF8, G, c); S.c0 = 120 % G;
            Epi1f E{ws, Sb};
            pg8::gemm_phase<Epi1f, pg8::F8Order, true>(lds, g, S, E);
        }
    }
    GRID_BAR();

    {
        u32x4 kr[4], vr[4];
#define ATT_STAGE_LOAD(UN) do { const int kvh_ = (UN) & 3, qb_ = ((UN) >> 2) & 15, b_ = (UN) >> 6, rowK0_ = b_ * SEQ + (qb_ - 1) * 128; \
        _Pragma("unroll") for (int it = 0; it < 4; ++it) { const int id = tid + 512 * it, j = id >> 3, cc = id & 7; \
            kr[it] = (u32x4){0u, 0u, 0u, 0u}; vr[it] = kr[it]; \
            if (qb_ > 0 || j >= 128) { kr[it] = *(const u32x4*)(Kb + (size_t)(rowK0_ + j) * 256 + kvh_ * 64 + cc * 8); vr[it] = *(const u32x4*)(Vb + (size_t)(rowK0_ + j) * 256 + kvh_ * 64 + cc * 8); } } } while (0)
        if (c < 512) ATT_STAGE_LOAD(c);
        const float* cw = a.in[6]; const float* st = a.in[4];
        const size_t NIT = (size_t)(MT / 4) * 128, NA = (G == 256) ? (NIT * 5 / 14) & ~(size_t)65535 : 0;
        const bool grpA = (G == 256) && c < 128;
        const size_t cbeg = grpA ? (size_t)c * 512 + tid : NA + (size_t)((G == 256) ? c - 128 : c) * 512 + tid, cend = grpA ? NA : NIT, cstr = (size_t)((G == 256) ? 128 : G) * 512;
        for (size_t it = cbeg; it < cend; it += cstr) {
            const int r0 = (int)(it >> 7) * 4, ch = (int)(it & 127) * 8;
            u32x4 uw[6], sw[4];
#pragma unroll
            for (int k = 0; k < 6; ++k) { const int rr = (r0 + k - 2 < 0) ? 0 : r0 + k - 2; uw[k] = *(const u32x4*)(Ub + (size_t)rr * 1024 + ch); }
#pragma unroll
            for (int k = 0; k < 4; ++k) sw[k] = *(const u32x4*)(Sb + (size_t)(r0 + k) * 1024 + ch);
            float w0[8], w1[8], w2[8];
#pragma unroll
            for (int h4 = 0; h4 < 2; ++h4) { const f32x4 a0 = *(const f32x4*)(cw + ch + 4 * h4), a1 = *(const f32x4*)(cw + 1024 + ch + 4 * h4), a2 = *(const f32x4*)(cw + 2048 + ch + 4 * h4);
#pragma unroll
                for (int e = 0; e < 4; ++e) { w0[4 * h4 + e] = a0[e]; w1[4 * h4 + e] = a1[e]; w2[4 * h4 + e] = a2[e]; } }
#pragma unroll
            for (int k = 0; k < 4; ++k) {
                const int row = r0 + k;
                float u0[8], u1[8], u2[8], sv[8];
#define UNP(dst, SRC_) do { const u32x4 q_ = (SRC_); dst[0] = bf_lo(q_[0]); dst[1] = bf_hi(q_[0]); dst[2] = bf_lo(q_[1]); dst[3] = bf_hi(q_[1]); dst[4] = bf_lo(q_[2]); dst[5] = bf_hi(q_[2]); dst[6] = bf_lo(q_[3]); dst[7] = bf_hi(q_[3]); } while (0)
                UNP(u0, uw[k]); UNP(u1, uw[k + 1]); UNP(u2, uw[k + 2]); UNP(sv, sw[k]);
#undef UNP
                int t; const float* sp = nullptr;
                if (row < MP) t = row & (SEQ - 1); else { const int r2 = row - MP; t = r2 & 7; sp = st + (size_t)(r2 >> 3) * 2048 + ch; }
                if (t < 1) {
#pragma unroll
                    for (int e = 0; e < 8; ++e) u1[e] = sp ? sp[1024 + e] : 0.f;
                }
                if (t < 2) {
#pragma unroll
                    for (int e = 0; e < 8; ++e) u0[e] = sp ? sp[t * 1024 + e] : 0.f;
                }
                float y[8];
#pragma unroll
                for (int e = 0; e < 8; ++e) y[e] = sv[e] * (w0[e] * u0[e] + w1[e] * u1[e] + w2[e] * u2[e]);
                u32x2 w; w.x = pk4_fp8(y[0] * YCSC, y[1] * YCSC, y[2] * YCSC, y[3] * YCSC); w.y = pk4_fp8(y[4] * YCSC, y[5] * YCSC, y[6] * YCSC, y[7] * YCSC);
                *(u32x2*)(YC + (size_t)row * 2048 + ch) = w;
            }
        }
        const float* sinks = a.in[7];
        LAS unsigned char* ldsV = lds + 32768;
        for (int un = c; un < 512; un += G) {
            const int kvh = un & 3, qb = (un >> 2) & 15, b = un >> 6;
            __syncthreads();
#pragma unroll
            for (int it = 0; it < 4; ++it) {
                const int id = tid + 512 * it, j = id >> 3, cc = id & 7;
                const u32x4 kv = kr[it], vv = vr[it];
                *(LAS u32x4*)(lds + j * 128 + ((cc ^ (j & 7)) * 16)) = kv;
                LAS unsigned short* vt = (LAS unsigned short*)(ldsV + (cc * 8) * 520 + j * 2);
                vt[0 * 260] = (unsigned short)(vv.x & 0xffffu); vt[1 * 260] = (unsigned short)(vv.x >> 16); vt[2 * 260] = (unsigned short)(vv.y & 0xffffu); vt[3 * 260] = (unsigned short)(vv.y >> 16);
                vt[4 * 260] = (unsigned short)(vv.z & 0xffffu); vt[5 * 260] = (unsigned short)(vv.z >> 16); vt[6 * 260] = (unsigned short)(vv.w & 0xffffu); vt[7 * 260] = (unsigned short)(vv.w >> 16);
            }
            if (un + G < 512) ATT_STAGE_LOAD(un + G);
            __syncthreads();
            if (wave >= 4) __builtin_amdgcn_s_sleep(31);
#pragma unroll 1
            for (int sbi = 0; sbi < 2; ++sbi) {
                const int sb = wave + 8 * sbi, gq = sb >> 2, i0 = (sb & 3) * 32;
                attn_sub<false>(Qb, ZA, YA, sinks, lds, i0, ldsV, 520, i0, b * SEQ + qb * 128 + i0, kvh * 4 + gq, i0, qb == 0, lane, lds + 66048 + wave * 8704);
            }
        }
#undef ATT_STAGE_LOAD
        for (int b = c; b < 128; b += G) {
            __syncthreads();
            {
                const int kvh = wave & 3;
                LAS unsigned char* kl = lds + kvh * 35088; LAS unsigned char* vl = kl + 17408;
                if (wave < 4 && lane < 4) *(LAS u32x4*)(vl + 64 * 272 + lane * 16) = (u32x4){0u, 0u, 0u, 0u};
                const float* ck = a.in[2]; const float* cv = a.in[3];
#pragma unroll 1
                for (int itb = (wave >> 2) * 8; itb < (wave >> 2) * 8 + 8; itb += 4) {
                    f32x4 k0s[4], k1s[4], v0s[4], v1s[4];
#pragma unroll
                    for (int u4 = 0; u4 < 4; ++u4) {
                        const int id = lane + 64 * (itb + u4), j = id >> 3, cc = id & 7;
                        const size_t so = ((size_t)(b * 128 + j) * 4 + kvh) * 64 + cc * 8;
                        k0s[u4] = *(const f32x4*)(ck + so); k1s[u4] = *(const f32x4*)(ck + so + 4); v0s[u4] = *(const f32x4*)(cv + so); v1s[u4] = *(const f32x4*)(cv + so + 4);
                    }
#pragma unroll
                    for (int u4 = 0; u4 < 4; ++u4) {
                        const int id = lane + 64 * (itb + u4), j = id >> 3, cc = id & 7;
                        const f32x4 k0 = k0s[u4], k1 = k1s[u4], v0 = v0s[u4], v1 = v1s[u4];
                        if (j >= 8) { const size_t dof = ((size_t)(b * 128 + j - 8) * 4 + kvh) * 64 + cc * 8;
                            *(f32x4*)(out + O_KS + dof) = k0; *(f32x4*)(out + O_KS + dof + 4) = k1; *(f32x4*)(out + O_VS + dof) = v0; *(f32x4*)(out + O_VS + dof + 4) = v1; }
                        u32x4 kw; kw.x = cvt_pk_bf16(k0[0], k0[1]); kw.y = cvt_pk_bf16(k0[2], k0[3]); kw.z = cvt_pk_bf16(k1[0], k1[1]); kw.w = cvt_pk_bf16(k1[2], k1[3]);
                        *(LAS u32x4*)(kl + j * 128 + ((cc ^ (j & 7)) * 16)) = kw;
                        const unsigned a0 = cvt_pk_bf16(v0[0], v0[1]), a1 = cvt_pk_bf16(v0[2], v0[3]), a2 = cvt_pk_bf16(v1[0], v1[1]), a3 = cvt_pk_bf16(v1[2], v1[3]);
                        LAS unsigned short* vt = (LAS unsigned short*)(vl + (cc * 8) * 272 + j * 2);
                        vt[0 * 136] = (unsigned short)(a0 & 0xffffu); vt[1 * 136] = (unsigned short)(a0 >> 16); vt[2 * 136] = (unsigned short)(a1 & 0xffffu); vt[3 * 136] = (unsigned short)(a1 >> 16);
                        vt[4 * 136] = (unsigned short)(a2 & 0xffffu); vt[5 * 136] = (unsigned short)(a2 >> 16); vt[6 * 136] = (unsigned short)(a3 & 0xffffu); vt[7 * 136] = (unsigned short)(a3 >> 16);
                    }
                }
                __syncthreads();
                if (wave < 4) {
                    const int jn = lane >> 3, cc = lane & 7, j = 128 + jn;
                    const u32x4 kv = *(const u32x4*)(Kb + (size_t)(MP + b * 8 + jn) * 256 + kvh * 64 + cc * 8), vv = *(const u32x4*)(Vb + (size_t)(MP + b * 8 + jn) * 256 + kvh * 64 + cc * 8);
                    *(LAS u32x4*)(kl + j * 128 + ((cc ^ (j & 7)) * 16)) = kv;
                    LAS unsigned short* vt = (LAS unsigned short*)(vl + (cc * 8) * 272 + j * 2);
                    vt[0 * 136] = (unsigned short)(vv.x & 0xffffu); vt[1 * 136] = (unsigned short)(vv.x >> 16); vt[2 * 136] = (unsigned short)(vv.y & 0xffffu); vt[3 * 136] = (unsigned short)(vv.y >> 16);
                    vt[4 * 136] = (unsigned short)(vv.z & 0xffffu); vt[5 * 136] = (unsigned short)(vv.z >> 16); vt[6 * 136] = (unsigned short)(vv.w & 0xffffu); vt[7 * 136] = (unsigned short)(vv.w >> 16);
                asm volatile("s_waitcnt lgkmcnt(0)" ::: "memory");
                attn_sub<true>(Qb, ZA, YA, sinks, kl, 0, vl, 272, 0, MP + b * 8, kvh * 4, 0, false, lane, kl + 128);
                }
            }
        }
        __syncthreads();
    }
    GRID_BAR();

    {
        pg8::Gemm g{(const bf16_t*)YC, (const bf16_t*)W2T, MT, DM, 512, 1024, 1024, DM / 2}; pg8::PairOrder S; S.so.init(MT, DM, G, c);
        Epi2 E{GC, GA, MG};
        pg8::gemm_phase<Epi2, pg8::PairOrder, true>(lds, g, S, E);
    }
    GRID_BAR();

    {
        pg8::Gemm g{(const bf16_t*)MG, (const bf16_t*)W3T, MT, DM, DM / 2, 0, 0, DM / 2}; pg8::StaticOrder S; S.init(MT, DM, G, c);
        Epi3 E{Sb};
        pg8::gemm_phase<Epi3, pg8::StaticOrder, true>(lds, g, S, E);
    }
    GRID_BAR();

    {
        f32x4 gg[8], bb[8];
#pragma unroll
        for (int j = 0; j < 8; ++j) { gg[j] = ((const f32x4*)a.in[11])[lane + 64 * j]; bb[j] = ((const f32x4*)a.in[12])[lane + 64 * j]; }
        for (int row = c * 8 + wave; row < MT; row += G * 8) {
            f32x4* zr = (f32x4*)(out + O_Y + (size_t)row * DM) + lane;
            const f32x4* xr = (const f32x4*)((row < MP) ? a.in[0] + (size_t)row * DM : a.in[1] + (size_t)(row - MP) * DM) + lane;
            const u32x2* orw = (const u32x2*)(Sb + (size_t)row * DM) + lane;
            f32x4 v[8]; float s = 0.f;
#pragma unroll
            for (int j = 0; j < 8; ++j) { const f32x4 xv = __builtin_nontemporal_load(xr + 64 * j); const u32x2 ow = orw[64 * j];
                v[j][0] = xv[0] * ALPHA + bf_lo(ow.x); v[j][1] = xv[1] * ALPHA + bf_hi(ow.x); v[j][2] = xv[2] * ALPHA + bf_lo(ow.y); v[j][3] = xv[3] * ALPHA + bf_hi(ow.y);
                s += (v[j][0] + v[j][1]) + (v[j][2] + v[j][3]); }
#pragma unroll
            for (int o = 1; o < 64; o <<= 1) s += __shfl_xor(s, o);
            const float mean = s * (1.f / DM); float s2 = 0.f;
#pragma unroll
            for (int j = 0; j < 8; ++j) { v[j] = v[j] - mean; s2 += (v[j][0] * v[j][0] + v[j][1] * v[j][1]) + (v[j][2] * v[j][2] + v[j][3] * v[j][3]); }
#pragma unroll
            for (int o = 1; o < 64; o <<= 1) s2 += __shfl_xor(s2, o);
            const float rstd = 1.0f / sqrtf(s2 * (1.f / DM) + LN_EPS);
#pragma unroll
            for (int j = 0; j < 8; ++j) __builtin_nontemporal_store(v[j] * rstd * gg[j] + bb[j], zr + 64 * j);
        }
    }
}

extern "C" void kernel_launch(void* const* d_in, const int* in_sizes, int n_in, void* d_out, int out_size, void* d_ws, size_t ws_size, hipStream_t stream) {
    static int grid_blocks = 0;
    if (grid_blocks == 0) {
        if (n_in != 13 || (size_t)out_size != O_END || ws_size < W_END) { fprintf(stderr, "kernel_launch: unexpected shapes (n_in %d, out %d, ws %zu)\n", n_in, out_size, ws_size); grid_blocks = -1; return; }
        int dev = 0, cus = 0, per_cu = 0;
        hipGetDevice(&dev);
        hipDeviceGetAttribute(&cus, hipDeviceAttributeMultiprocessorCount, dev);
        if (hipFuncSetAttribute((const void*)hybrid_fwd, hipFuncAttributeMaxDynamicSharedMemorySize, LDS_BYTES) != hipSuccess) { fprintf(stderr, "kernel_launch: hipFuncSetAttribute failed\n"); grid_blocks = -1; return; }
        if (hipOccupancyMaxActiveBlocksPerMultiprocessor(&per_cu, (const void*)hybrid_fwd, 512, LDS_BYTES) != hipSuccess || per_cu < 1) { fprintf(stderr, "kernel_launch: occupancy query failed (%d)\n", per_cu); (void)hipGetLastError(); per_cu = 1; }
        grid_blocks = cus * per_cu;
    }
    if (grid_blocks < 0) return;
    if (hipMemsetAsync((char*)d_ws + W_CTL, 0, CTL_BYTES, stream) != hipSuccess) { fprintf(stderr, "kernel_launch: hipMemsetAsync failed\n"); return; }
    Args a{};
    for (int i = 0; i < 13; ++i) a.in[i] = (const float*)d_in[i];
    a.out = (float*)d_out; a.ws = (unsigned char*)d_ws;
    void* args[] = {&a};
    hipError_t e = hipLaunchCooperativeKernel((const void*)hybrid_fwd, dim3(grid_blocks), dim3(512), args, LDS_BYTES, stream);
    if (e != hipSuccess) fprintf(stderr, "cooperative launch failed: %s (grid %d)\n", hipGetErrorString(e), grid_blocks);
}
```

```cpp
#include <hip/hip_runtime.h>
#include <hip/hip_cooperative_groups.h>
#include <cstdio>
#include <cstdint>
namespace cg = cooperative_groups;

#define LAS __attribute__((address_space(3)))
typedef unsigned short bf16_t;
typedef short bf16x8 __attribute__((ext_vector_type(8)));
typedef short s16x4 __attribute__((ext_vector_type(4)));
typedef float f32x4 __attribute__((ext_vector_type(4)));
typedef float f32x16 __attribute__((ext_vector_type(16)));
typedef unsigned u32x4 __attribute__((ext_vector_type(4)));
typedef unsigned u32x2 __attribute__((ext_vector_type(2)));
typedef int i32x4 __attribute__((ext_vector_type(4)));
typedef int i32x8 __attribute__((ext_vector_type(8)));

constexpr int DM = 2048, MP = 16384, MS = 1024, MT = MP + MS, NIN = 10752, SEQ = 2048;
constexpr float LOG2E = 1.4426950408889634f;
constexpr float QSCALE = 0.125f * LOG2E;
constexpr float ALPHA = 1.189207115002721f;
constexpr float LN_EPS = 1e-5f;
constexpr float WSC = 64.f, MSC = 16.f, XSC = 8.f, YCSC = 8.f, YASC = 16.f;
constexpr size_t O_Y = 0, O_KP = (size_t)MT * DM, O_VP = O_KP + 8 * 128 * 256, O_CP = O_VP + 8 * 128 * 256, O_KS = O_CP + 8 * 2 * 1024,
                 O_VS = O_KS + (size_t)128 * 128 * 256, O_CS = O_VS + (size_t)128 * 128 * 256, O_END = O_CS + 128 * 2 * 1024;
constexpr int NB16 = 2560, NF8 = 8192;
constexpr size_t W_W1B = 0;
constexpr size_t W_W18 = W_W1B + (size_t)NB16 * DM * 2;
constexpr size_t W_W2T = W_W18 + (size_t)(NF8 + NB16) * DM;
constexpr size_t W_W3T = W_W2T + 2ull * DM * 1024;
constexpr size_t W_XB = W_W3T + (size_t)DM * DM;
constexpr size_t W_X8 = W_XB + (size_t)MT * DM * 2;
constexpr size_t W_S = W_X8 + (size_t)MT * DM;
constexpr size_t W_U = W_S + (size_t)MT * 1024 * 2;
constexpr size_t W_Q = W_U + (size_t)MT * 1024 * 2;
constexpr size_t W_K = W_Q + (size_t)MT * 1024 * 2;
constexpr size_t W_V = W_K + (size_t)MT * 256 * 2;
constexpr size_t W_ZA = W_V + (size_t)MT * 256 * 2;
constexpr size_t W_GC = W_ZA + (size_t)MT * 1024 * 2;
constexpr size_t W_GA = W_GC + (size_t)MT * DM * 2;
constexpr size_t W_YCA = W_GA + (size_t)MT * DM * 2;
constexpr size_t W_CTL = W_YCA + 2ull * MT * 1024;
constexpr size_t CTL_BYTES = 16384;
constexpr size_t W_END = W_CTL + CTL_BYTES;
constexpr int LDS_BYTES = 147456;

__device__ __forceinline__ unsigned cvt_pk_bf16(float lo, float hi) { unsigned r; asm volatile("v_cvt_pk_bf16_f32 %0, %1, %2" : "=v"(r) : "v"(lo), "v"(hi)); return r; }
__device__ __forceinline__ float bf_lo(unsigned u) { return __uint_as_float(u << 16); }
__device__ __forceinline__ float bf_hi(unsigned u) { return __uint_as_float(u & 0xffff0000u); }
__device__ __forceinline__ unsigned pk4_fp8(float a, float b, float c, float d) {
    a = __builtin_amdgcn_fmed3f(a, -448.f, 448.f); b = __builtin_amdgcn_fmed3f(b, -448.f, 448.f); c = __builtin_amdgcn_fmed3f(c, -448.f, 448.f); d = __builtin_amdgcn_fmed3f(d, -448.f, 448.f);
    unsigned w = 0u; w = __builtin_amdgcn_cvt_pk_fp8_f32(a, b, w, false); w = __builtin_amdgcn_cvt_pk_fp8_f32(c, d, w, true); return w; }
__device__ __forceinline__ float sigm(float x) { return __builtin_amdgcn_rcpf(1.0f + __builtin_amdgcn_exp2f(-x * LOG2E)); }

namespace pg8 {
constexpr int BM = 256, BK = 64, HALF = 128, HTB = HALF * BK * 2, STAGE_BYTES = 8 * HTB, NXCD = 8, WGM = 8;
__host__ __device__ __forceinline__ int lds_byte(int r, int c) { const int st = (r >> 4) * 2 + (c >> 5), rr = r & 15, cc = c & 31, ob = rr * 64 + cc * 2; return st * 1024 + (ob ^ (((ob >> 9) & 1) << 5)); }
__host__ __device__ __forceinline__ void stage_rc(int b, int& R, int& C) { const int st = b / 1024, sb = b % 1024, swz = sb ^ (((sb >> 9) & 1) << 5); R = (st >> 1) * 16 + swz / 64; C = (st & 1) * 32 + (swz % 64) / 2; }
__host__ __device__ __forceinline__ int perm32(int rho) { const int n = rho >> 4, i = rho & 15; return 8 * (i >> 2) + 4 * n + (i & 3); }

struct Unit { int pm, pn, z; };
struct Gemm { const bf16_t* A; const bf16_t* Bt; int M, N, K; size_t zA, zB; int ld; };

struct StaticOrder {
    int nM, nN, nwg, G, c;
    __device__ void init(int M, int N, int G_, int c_) { nM = M / BM; nN = N / BM; nwg = nM * nN; G = G_; c = c_; }
    __device__ bool next(int i, Unit& u) const {
        const long L = (long)i * G + c; u.z = 0; if (L >= nwg) return false;
        int wgid = (int)L; { const int q = nwg / NXCD, r = nwg % NXCD, xcd = wgid % NXCD, off = wgid / NXCD; wgid = (xcd < r ? xcd * (q + 1) : r * (q + 1) + (xcd - r) * q) + off; }
        const int nig = WGM * nN, gid = wgid / nig, fm = gid * WGM, gsz = (nM - fm) < WGM ? (nM - fm) : WGM;
        u.pm = fm + ((wgid % nig) % gsz); u.pn = (wgid % nig) / gsz; return true;
    }
};
struct TailOrder {
    StaticOrder so; int c0;
    __device__ bool next(int i, Unit& u) const {
        const int full = so.nwg / so.G; StaticOrder t = so;
        if (i < full) return so.next(i, u);
        const int cc = so.c - c0; u.z = 0; if (cc < 0) return false;
        const int L = full * so.G + (i - full) * (so.G - c0) + cc; if (L >= so.nwg) return false;
        t.c = L; return t.next(0, u);
    }
};
struct CritOrder {
    int G, c;
    __device__ bool next(int i, Unit& u) const { const int L = i * G + c; u.z = 0; if (L >= 120) return false; const int p = L % 12; u.pn = L / 12; u.pm = (p < 8) ? 8 * p + 7 : 56 + p; return true; }
};
struct F8Order {
    StaticOrder so; int c0;
    static constexpr int N1 = 68 * 32, N2 = 56 * 10, NT = N1 + N2;
    __device__ bool next(int i, Unit& u) const {
        const int full = NT / so.G; int L; u.z = 0;
        if (i < full) L = i * so.G + so.c;
        else { const int cc = so.c - c0; if (cc < 0) return false; L = full * so.G + (i - full) * (so.G - c0) + cc; }
        if (L >= NT) return false;
        if (L < N1) { StaticOrder t = so; t.c = L; return t.next(0, u); }
        int l2 = L - N1; if ((so.G & 7) == 0) l2 = (l2 & 7) * (N2 / 8) + (l2 >> 3);
        const int grp = l2 / 80, r = l2 % 80, pmq = grp * 8 + (r & 7);
        u.pn = 32 + (r >> 3); u.pm = (pmq / 7) * 8 + pmq % 7; return true;
    }
};
struct PairOrder {
    StaticOrder so;
    __device__ bool next(int i, Unit& u) const { const bool ok = so.next(i >> 1, u); u.z = i & 1; return ok; }
};

template <class Epi, class Sched, bool F8 = false>
__device__ __forceinline__ void gemm_phase(LAS unsigned char* lds, const Gemm g, const Sched& S, const Epi& E) {
    const int tid = threadIdx.x, wid = __builtin_amdgcn_readfirstlane(tid >> 6), lane = tid & 63, wr = wid >> 2, wc = wid & 3, fr = lane & 15, fq = lane >> 4;
    const int K = g.ld, nt = g.K / BK;
    unsigned voffA[2], voffB[2];
#pragma unroll
    for (int i = 0; i < 2; ++i) { int R, C; stage_rc(tid * 16 + i * 8192, R, C); const int Rb = Epi::PERM ? ((R & ~31) + perm32(R & 31)) : R;
        voffA[i] = (unsigned)(R * K + C) * 2u; voffB[i] = (unsigned)(Rb * K + C) * 2u; }
    const size_t kstep = (size_t)(BK * 2);
    const size_t hstep = (size_t)HALF * K * 2;
    const size_t tstep = 2 * hstep;
    const unsigned ldsw = (unsigned)wid * 1024u;
    const int aoff = lds_byte(wr * 64 + fr, fq * 8), boff = lds_byte(wc * 32 + fr, fq * 8);
#define PG8_SA(b, h) (((b) * 2 + (h)) * HTB)
#define PG8_SB(b, h) ((4 + (b) * 2 + (h)) * HTB)
#define PG8_STAGE(bufoff, gbase, voff) do { _Pragma("unroll") for (int _i = 0; _i < 2; ++_i) \
        __builtin_amdgcn_global_load_lds((const unsigned*)((const char*)(gbase) + (voff)[_i]), (LAS unsigned*)(lds + (bufoff) + ldsw + _i * 8192), 16, 0, 0); } while (0)
#define PG8_LDA(dst, b, h) do { if constexpr (F8) { _Pragma("unroll") for (int m = 0; m < 4; ++m) { const i32x4 lo_ = *(const LAS i32x4*)(lds + PG8_SA(b, h) + aoff + m * 2048), hi_ = *(const LAS i32x4*)(lds + PG8_SA(b, h) + aoff + m * 2048 + 1024); \
            dst##8[m] = __builtin_shufflevector(lo_, hi_, 0, 1, 2, 3, 4, 5, 6, 7); } } else { \
        _Pragma("unroll") for (int m = 0; m < 4; ++m) _Pragma("unroll") for (int k = 0; k < 2; ++k) dst[m][k] = *(const LAS bf16x8*)(lds + PG8_SA(b, h) + aoff + m * 2048 + k * 1024); } } while (0)
#define PG8_LDB(dst, b, h) do { if constexpr (F8) { _Pragma("unroll") for (int n = 0; n < 2; ++n) { const i32x4 lo_ = *(const LAS i32x4*)(lds + PG8_SB(b, h) + boff + n * 2048), hi_ = *(const LAS i32x4*)(lds + PG8_SB(b, h) + boff + n * 2048 + 1024); \
            dst##8[n] = __builtin_shufflevector(lo_, hi_, 0, 1, 2, 3, 4, 5, 6, 7); } } else { \
        _Pragma("unroll") for (int n = 0; n < 2; ++n) _Pragma("unroll") for (int k = 0; k < 2; ++k) dst[n][k] = *(const LAS bf16x8*)(lds + PG8_SB(b, h) + boff + n * 2048 + k * 1024); } } while (0)
#define PG8_MMA(ai, bj, At, Bt) do { __builtin_amdgcn_s_setprio(1); if constexpr (F8) { _Pragma("unroll") for (int m = 0; m < 4; ++m) _Pragma("unroll") for (int n = 0; n < 2; ++n) \
        asm volatile("v_mfma_f32_16x16x128_f8f6f4 %0, %1, %2, %0" : "+v"(acc[ai][bj][m][n]) : "v"(Bt##8[n]), "v"(At##8[m])); } else { \
        _Pragma("unroll") for (int m = 0; m < 4; ++m) _Pragma("unroll") for (int n = 0; n < 2; ++n) _Pragma("unroll") for (int k = 0; k < 2; ++k) \
        acc[ai][bj][m][n] = __builtin_amdgcn_mfma_f32_16x16x32_bf16(Bt[n][k], At[m][k], acc[ai][bj][m][n], 0, 0, 0); } __builtin_amdgcn_s_setprio(0); } while (0)
#define PG8_WAIT_V(n) asm volatile("s_waitcnt vmcnt(" #n ")" ::: "memory")
#define PG8_WAIT_L(n) asm volatile("s_waitcnt lgkmcnt(" #n ")" ::: "memory")
#define PG8_BAR __builtin_amdgcn_s_barrier()
#define PG8_SCHED __builtin_amdgcn_sched_barrier(0)
    Unit cur, nxt; int ui = 0;
    if (!S.next(0, cur)) return;
    f32x4 acc[2][2][4][2];
#pragma unroll
    for (int a = 0; a < 2; ++a)
#pragma unroll
        for (int b = 0; b < 2; ++b)
#pragma unroll
            for (int m = 0; m < 4; ++m)
#pragma unroll
                for (int n = 0; n < 2; ++n) acc[a][b][m][n] = (f32x4){0.f, 0.f, 0.f, 0.f};
    bf16x8 At[4][2], B0[2][2], B1[2][2]; i32x8 At8[4], B08[2], B18[2];
    const char* cA = (const char*)g.A + (size_t)cur.z * g.zA + (size_t)cur.pm * tstep; const char* cB = (const char*)g.Bt + (size_t)cur.z * g.zB + (size_t)cur.pn * tstep;
    PG8_STAGE(PG8_SB(0, 0), cB, voffB); PG8_STAGE(PG8_SB(0, 1), cB + hstep, voffB); PG8_STAGE(PG8_SA(0, 0), cA, voffA); PG8_STAGE(PG8_SA(0, 1), cA + hstep, voffA);
    if (wr == 1) PG8_BAR;
    PG8_WAIT_V(2); PG8_BAR;
    PG8_STAGE(PG8_SB(1, 0), cB + kstep, voffB); PG8_STAGE(PG8_SA(1, 0), cA + kstep, voffA); PG8_STAGE(PG8_SB(1, 1), cB + hstep + kstep, voffB);
    PG8_WAIT_V(6); PG8_BAR;
    for (;;) {
        const bool has_next = S.next(ui + 1, nxt);
        const char* nA = has_next ? (const char*)g.A + (size_t)nxt.z * g.zA + (size_t)nxt.pm * tstep : cA; const char* nB = has_next ? (const char*)g.Bt + (size_t)nxt.z * g.zB + (size_t)nxt.pn * tstep : cB;
        for (int t = 0; t < nt; t += 2) {
            const bool last = (t == nt - 2);
            const char* a1 = cA + (size_t)(t + 1) * kstep;
            const char* a2 = last ? nA : cA + (size_t)(t + 2) * kstep; const char* b2 = last ? nB : cB + (size_t)(t + 2) * kstep;
            const char* a3 = a2 + kstep; const char* b3 = b2 + kstep;
            PG8_LDB(B0, 0, 0); PG8_LDB(B1, 0, 1); PG8_SCHED; PG8_LDA(At, 0, 0); PG8_STAGE(PG8_SA(1, 1), a1 + hstep, voffA);
            PG8_WAIT_V(8); PG8_WAIT_L(0); PG8_BAR; PG8_MMA(0, 0, At, B0); PG8_MMA(0, 1, At, B1); PG8_BAR; PG8_SCHED;
            PG8_LDA(At, 0, 1); PG8_STAGE(PG8_SB(0, 0), b2, voffB); PG8_STAGE(PG8_SB(0, 1), b2 + hstep, voffB); PG8_STAGE(PG8_SA(0, 0), a2, voffA);
            PG8_WAIT_V(8); PG8_WAIT_L(0); PG8_BAR; PG8_MMA(1, 0, At, B0); PG8_MMA(1, 1, At, B1); PG8_BAR; PG8_SCHED;
            PG8_LDB(B0, 1, 0); PG8_LDB(B1, 1, 1); PG8_SCHED; PG8_LDA(At, 1, 0); PG8_STAGE(PG8_SA(0, 1), a2 + hstep, voffA);
            PG8_WAIT_V(8); PG8_WAIT_L(0); PG8_BAR; PG8_MMA(0, 0, At, B0); PG8_MMA(0, 1, At, B1); PG8_BAR; PG8_SCHED;
            PG8_LDA(At, 1, 1); PG8_STAGE(PG8_SB(1, 0), b3, voffB); PG8_STAGE(PG8_SB(1, 1), b3 + hstep, voffB); PG8_STAGE(PG8_SA(1, 0), a3, voffA);
            PG8_WAIT_V(8); PG8_WAIT_L(0); PG8_BAR; PG8_MMA(1, 0, At, B0); PG8_MMA(1, 1, At, B1); PG8_BAR; PG8_SCHED;
        }
        if (wr == 0) PG8_BAR;
        if constexpr (F8) asm volatile("s_nop 15\n\ts_nop 15" ::: "memory");
        E(acc, cur, wr, wc, fr, fq);
        if (!has_next) break;
        if (!(Epi::MID && cur.z == 0)) {
#pragma unroll
        for (int a = 0; a < 2; ++a)
#pragma unroll
            for (int b = 0; b < 2; ++b)
#pragma unroll
                for (int m = 0; m < 4; ++m)
#pragma unroll
                    for (int n = 0; n < 2; ++n) acc[a][b][m][n] = (f32x4){0.f, 0.f, 0.f, 0.f};
        }
        cur = nxt; cA = nA; cB = nB; ++ui;
        if (wr == 1) PG8_BAR;
    }
    PG8_WAIT_V(0);
    PG8_BAR;
#undef PG8_SA
#undef PG8_SB
#undef PG8_STAGE
#undef PG8_LDA
#undef PG8_LDB
#undef PG8_MMA
#undef PG8_WAIT_V
#undef PG8_WAIT_L
#undef PG8_BAR
#undef PG8_SCHED
}
}

struct Epi1b {
    static constexpr bool MID = false;
    static constexpr bool PERM = true;
    bf16_t *U, *Kb, *Vb; float* out;
    __device__ __forceinline__ void operator()(const f32x4 (&acc)[2][2][4][2], const pg8::Unit& u, int wr, int wc, int fr, int fq) const {
        const int row0 = u.pm * 256 + wr * 64 + fr, pn = u.pn;
        if (pn < 8) {
#pragma unroll
            for (int ai = 0; ai < 2; ++ai)
#pragma unroll
                for (int m = 0; m < 4; ++m) {
                    const int row = row0 + ai * 128 + m * 16;
#pragma unroll
                    for (int bj = 0; bj < 2; ++bj) {
                        const int ch = pn * 128 + bj * 64 + wc * 16 + fq * 4;
                        const f32x4 uu = acc[ai][bj][m][0] * acc[ai][bj][m][1];
                        u32x2 wu_; wu_.x = cvt_pk_bf16(uu[0], uu[1]); wu_.y = cvt_pk_bf16(uu[2], uu[3]);
                        *(u32x2*)(U + (size_t)row * 1024 + ch) = wu_;
                        if (row < MP) { const int t = row & (SEQ - 1); if (t >= SEQ - 2) *(f32x4*)(out + O_CP + (size_t)((row >> 11) * 2 + (t - (SEQ - 2))) * 1024 + ch) = uu; }
                        else { const int r2 = row - MP, i = r2 & 7; if (i >= 6) *(f32x4*)(out + O_CS + (size_t)((r2 >> 3) * 2 + (i - 6)) * 1024 + ch) = uu; }
                    }
                }
        } else {
            bf16_t* dst = (pn == 8) ? Kb : Vb;
            const size_t op = (pn == 8) ? O_KP : O_VP, os = (pn == 8) ? O_KS : O_VS;
            const int col0 = wc * 32 + 8 * fq;
#pragma unroll
            for (int ai = 0; ai < 2; ++ai)
#pragma unroll
                for (int m = 0; m < 4; ++m) {
                    const int row = row0 + ai * 128 + m * 16; float* dp = nullptr;
                    if (row < MP) { const int t = row & (SEQ - 1); if (t >= SEQ - 128) dp = out + op + (size_t)((row >> 11) * 128 + (t - (SEQ - 128))) * 256; }
                    else { const int r2 = row - MP; dp = out + os + (size_t)((r2 >> 3) * 128 + 120 + (r2 & 7)) * 256; }
#pragma unroll
                    for (int bj = 0; bj < 2; ++bj) {
                        const f32x4 v0 = acc[ai][bj][m][0], v1 = acc[ai][bj][m][1];
                        u32x4 w; w.x = cvt_pk_bf16(v0[0], v0[1]); w.y = cvt_pk_bf16(v0[2], v0[3]); w.z = cvt_pk_bf16(v1[0], v1[1]); w.w = cvt_pk_bf16(v1[2], v1[3]);
                        *(u32x4*)(dst + (size_t)row * 256 + col0 + bj * 128) = w;
                        if (dp) { float* p = dp + bj * 128 + col0; *(f32x4*)p = v0; *(f32x4*)(p + 4) = v1; }
                    }
                }
        }
    }
};
struct Epi1f {
    static constexpr bool MID = false;
    static constexpr bool PERM = true;
    unsigned char* ws; bf16_t* S;
    __device__ __forceinline__ void operator()(const f32x4 (&acc)[2][2][4][2], const pg8::Unit& u, int wr, int wc, int fr, int fq) const {
        const int row0 = u.pm * 256 + wr * 64 + fr, pn = u.pn;
        constexpr float US = 1.0f / (XSC * WSC);
        if (pn < 8) {
#pragma unroll
            for (int ai = 0; ai < 2; ++ai)
#pragma unroll
                for (int m = 0; m < 4; ++m) {
                    const int row = row0 + ai * 128 + m * 16;
#pragma unroll
                    for (int bj = 0; bj < 2; ++bj) {
                        const int ch = pn * 128 + bj * 64 + wc * 16 + fq * 4;
                        const f32x4 gb = acc[ai][bj][m][0] * US, zc = acc[ai][bj][m][1] * US; f32x4 sv;
#pragma unroll
                        for (int e = 0; e < 4; ++e) sv[e] = zc[e] * sigm(zc[e]) * gb[e];
                        u32x2 w_; w_.x = cvt_pk_bf16(sv[0], sv[1]); w_.y = cvt_pk_bf16(sv[2], sv[3]);
                        *(u32x2*)(S + (size_t)row * 1024 + ch) = w_;
                    }
                }
        } else {
            if (pn >= 32) {
                if (pn < 40) {
#pragma unroll
                    for (int ai = 0; ai < 2; ++ai)
#pragma unroll
                        for (int m = 0; m < 4; ++m) {
                            const int row = row0 + ai * 128 + m * 16;
#pragma unroll
                            for (int bj = 0; bj < 2; ++bj) {
                                const int ch = (pn - 32) * 128 + bj * 64 + wc * 16 + fq * 4;
                                const f32x4 uu = acc[ai][bj][m][0] * acc[ai][bj][m][1] * (US * US);
                                u32x2 wu_; wu_.x = cvt_pk_bf16(uu[0], uu[1]); wu_.y = cvt_pk_bf16(uu[2], uu[3]);
                                *(u32x2*)((bf16_t*)(ws + W_U) + (size_t)row * 1024 + ch) = wu_;
                            }
                        }
                } else {
                    bf16_t* dst = (bf16_t*)(ws + (pn == 40 ? W_K : W_V));
#pragma unroll
                    for (int ai = 0; ai < 2; ++ai)
#pragma unroll
                        for (int m = 0; m < 4; ++m) {
                            bf16_t* rowp = dst + (size_t)(row0 + ai * 128 + m * 16) * 256 + wc * 32 + 8 * fq;
#pragma unroll
                            for (int bj = 0; bj < 2; ++bj) {
                                const f32x4 v0 = acc[ai][bj][m][0] * US, v1 = acc[ai][bj][m][1] * US;
                                u32x4 w; w.x = cvt_pk_bf16(v0[0], v0[1]); w.y = cvt_pk_bf16(v0[2], v0[3]); w.z = cvt_pk_bf16(v1[0], v1[1]); w.w = cvt_pk_bf16(v1[2], v1[3]);
                                *(u32x4*)(rowp + bj * 128) = w;
                            }
                        }
                }
                return;
            }
            if (pn >= 16) {
#pragma unroll
                for (int ai = 0; ai < 2; ++ai)
#pragma unroll
                    for (int m = 0; m < 4; ++m) {
                        const int row = row0 + ai * 128 + m * 16;
#pragma unroll
                        for (int bj = 0; bj < 2; ++bj) {
                            const int col = (pn - 16) * 128 + bj * 64 + wc * 16 + fq * 4;
                            f32x4 rr, sa;
#pragma unroll
                            for (int e = 0; e < 4; ++e) {
                                const float ec = __builtin_amdgcn_exp2f(acc[ai][bj][m][0][e] * (-US * LOG2E)), ea = fminf(__builtin_amdgcn_exp2f(acc[ai][bj][m][1][e] * (-US * LOG2E)), 1.152921504606847e18f);
                                sa[e] = __builtin_amdgcn_rcpf(1.0f + ea); rr[e] = ((YASC / YCSC) + (YASC / YCSC) * ea) * __builtin_amdgcn_rcpf(1.0f + ec);
                            }
                            u32x2 w1, w2; w1.x = cvt_pk_bf16(rr[0], rr[1]); w1.y = cvt_pk_bf16(rr[2], rr[3]); w2.x = cvt_pk_bf16(sa[0], sa[1]); w2.y = cvt_pk_bf16(sa[2], sa[3]);
                            *(u32x2*)((bf16_t*)(ws + W_GC) + (size_t)row * 2048 + col) = w1; *(u32x2*)((bf16_t*)(ws + W_GA) + (size_t)row * 2048 + col) = w2;
                        }
                    }
                return;
            }
            unsigned long long doff; int ld, colt, act; float scale = US;
            if (pn < 12) { doff = W_Q; ld = 1024; colt = (pn - 8) * 256; act = 0; scale = QSCALE * US; }
            else { doff = W_ZA; ld = 1024; colt = (pn - 12) * 256; act = 1; }
            bf16_t* dst = (bf16_t*)(ws + doff);
            const int col0 = colt + wc * 32 + 8 * fq;
#pragma unroll
            for (int ai = 0; ai < 2; ++ai)
#pragma unroll
                for (int m = 0; m < 4; ++m) {
                    bf16_t* rowp = dst + (size_t)(row0 + ai * 128 + m * 16) * ld + col0;
#pragma unroll
                    for (int bj = 0; bj < 2; ++bj) {
                        float v[8];
#pragma unroll
                        for (int e = 0; e < 4; ++e) { v[e] = acc[ai][bj][m][0][e] * scale; v[4 + e] = acc[ai][bj][m][1][e] * scale; }
                        if (act != 0) {
#pragma unroll
                            for (int e = 0; e < 8; ++e) v[e] = v[e] * sigm(v[e]);
                        }
                        u32x4 w; w.x = cvt_pk_bf16(v[0], v[1]); w.y = cvt_pk_bf16(v[2], v[3]); w.z = cvt_pk_bf16(v[4], v[5]); w.w = cvt_pk_bf16(v[6], v[7]);
                        *(u32x4*)(rowp + bj * 128) = w;
                    }
                }
        }
    }
};
struct Epi2 {
    static constexpr bool PERM = true, MID = true;
    const bf16_t *R, *SA; unsigned char* MG;
    __device__ __forceinline__ void mid(f32x4 (&acc)[2][2][4][2], const pg8::Unit& u, int wr, int wc, int fr, int fq) const {
        const int row0 = u.pm * 256 + wr * 64 + fr, col0 = u.pn * 256 + wc * 32 + 8 * fq;
#pragma unroll
        for (int ai = 0; ai < 2; ++ai)
#pragma unroll
            for (int m = 0; m < 4; ++m) {
                const size_t ro = (size_t)(row0 + ai * 128 + m * 16) * 2048 + col0;
#pragma unroll
                for (int bj = 0; bj < 2; ++bj) {
                    const u32x4 gw = *(const u32x4*)(R + ro + bj * 128);
                    acc[ai][bj][m][0][0] *= bf_lo(gw.x); acc[ai][bj][m][0][1] *= bf_hi(gw.x); acc[ai][bj][m][0][2] *= bf_lo(gw.y); acc[ai][bj][m][0][3] *= bf_hi(gw.y);
                    acc[ai][bj][m][1][0] *= bf_lo(gw.z); acc[ai][bj][m][1][1] *= bf_hi(gw.z); acc[ai][bj][m][1][2] *= bf_lo(gw.w); acc[ai][bj][m][1][3] *= bf_hi(gw.w);
                }
            }
    }
    __device__ __forceinline__ void operator()(f32x4 (&acc)[2][2][4][2], const pg8::Unit& u, int wr, int wc, int fr, int fq) const {
        if (u.z == 0) { mid(acc, u, wr, wc, fr, fq); return; }
        const int row0 = u.pm * 256 + wr * 64 + fr, col0 = u.pn * 256 + wc * 32 + 8 * fq;
        constexpr float us = MSC / (YASC * WSC);
#pragma unroll
        for (int ai = 0; ai < 2; ++ai) {
            u32x4 gws[4][2];
#pragma unroll
            for (int m = 0; m < 4; ++m)
#pragma unroll
                for (int bj = 0; bj < 2; ++bj) gws[m][bj] = *(const u32x4*)(SA + (size_t)(row0 + ai * 128 + m * 16) * 2048 + col0 + bj * 128);
#pragma unroll
            for (int m = 0; m < 4; ++m) {
                const size_t ro = (size_t)(row0 + ai * 128 + m * 16) * 2048 + col0;
#pragma unroll
                for (int bj = 0; bj < 2; ++bj) {
                    const u32x4 gw = gws[m][bj];
                    f32x4 v0 = acc[ai][bj][m][0] * us, v1 = acc[ai][bj][m][1] * us;
                    v0[0] *= bf_lo(gw.x); v0[1] *= bf_hi(gw.x); v0[2] *= bf_lo(gw.y); v0[3] *= bf_hi(gw.y);
                    v1[0] *= bf_lo(gw.z); v1[1] *= bf_hi(gw.z); v1[2] *= bf_lo(gw.w); v1[3] *= bf_hi(gw.w);
                    u32x2 w; w.x = pk4_fp8(v0[0], v0[1], v0[2], v0[3]); w.y = pk4_fp8(v1[0], v1[1], v1[2], v1[3]);
                    *(u32x2*)(MG + ro + bj * 128) = w;
                }
            }
        }
    }
};
struct Epi3 {
    static constexpr bool PERM = true, MID = false;
    bf16_t* OB;
    __device__ __forceinline__ void operator()(const f32x4 (&acc)[2][2][4][2], const pg8::Unit& u, int wr, int wc, int fr, int fq) const {
        const int row0 = u.pm * 256 + wr * 64 + fr, col0 = u.pn * 256 + wc * 32 + 8 * fq;
        constexpr float us = 1.0f / (WSC * MSC);
#pragma unroll
        for (int ai = 0; ai < 2; ++ai)
#pragma unroll
            for (int m = 0; m < 4; ++m) {
                bf16_t* rowp = OB + (size_t)(row0 + ai * 128 + m * 16) * DM + col0;
#pragma unroll
                for (int bj = 0; bj < 2; ++bj) {
                    const f32x4 v0 = acc[ai][bj][m][0] * us, v1 = acc[ai][bj][m][1] * us;
                    u32x4 w; w.x = cvt_pk_bf16(v0[0], v0[1]); w.y = cvt_pk_bf16(v0[2], v0[3]); w.z = cvt_pk_bf16(v1[0], v1[1]); w.w = cvt_pk_bf16(v1[2], v1[3]);
                    *(u32x4*)(rowp + bj * 128) = w;
                }
            }
    }
};

__device__ __forceinline__ int pair_row(int chn, int n) { const int pn = chn >> 7, cl = chn & 127, bj = cl >> 6, wc = (cl >> 4) & 3, fq = (cl >> 2) & 3, e = cl & 3; return pn * 256 + bj * 128 + wc * 32 + fq * 8 + n * 4 + e; }
__device__ __forceinline__ int map_w1(int nsrc, bool& f8) {
    if (nsrc < 1024) { f8 = true; return pair_row(nsrc, 0); }
    if (nsrc < 2048) { f8 = false; return pair_row(nsrc - 1024, 0); }
    if (nsrc < 3072) { f8 = false; return pair_row(nsrc - 2048, 1); }
    if (nsrc < 4096) { f8 = true; return pair_row(nsrc - 3072, 1); }
    if (nsrc < 5120) { f8 = true; return 2048 + (nsrc - 4096); }
    if (nsrc < 5376) { f8 = false; return 2048 + (nsrc - 5120); }
    if (nsrc < 5632) { f8 = false; return 2304 + (nsrc - 5376); }
    if (nsrc < 6656) { f8 = true; return 3072 + (nsrc - 5632); }
    if (nsrc < 8704) { f8 = true; return 4096 + pair_row(nsrc - 6656, 0); }
    f8 = true; return 4096 + pair_row(nsrc - 8704, 1);
}
template <int MODE>
__device__ __forceinline__ void transpose_item(const float* __restrict__ W, int K, int N, bf16_t* __restrict__ WTb, unsigned char* __restrict__ WT8, int ldk, int koff, LAS float* scr, int item, int lane) {
    const int nblk = N / 32, kb = item / nblk, nb = item % nblk, k0 = 64 * kb, n0 = 32 * nb;
    const int c = lane & 7;
    {   f32x4 v[8];
#pragma unroll
        for (int i = 0; i < 8; ++i) v[i] = __builtin_nontemporal_load((const f32x4*)(W + (size_t)(k0 + 8 * i + (lane >> 3)) * N + n0 + 4 * c));
#pragma unroll
        for (int i = 0; i < 8; ++i) { LAS float* d = scr + (8 * i + (lane >> 3)) * 33 + 4 * c; d[0] = v[i][0]; d[1] = v[i][1]; d[2] = v[i][2]; d[3] = v[i][3]; }
    }
    asm volatile("s_waitcnt lgkmcnt(0)" ::: "memory");
#pragma unroll
    for (int j = 0; j < 4; ++j) { const int n = (lane >> 3) + 8 * j; const LAS float* sp = scr + (8 * c) * 33 + n;
        bool f8 = true; const int drow = (MODE == 1) ? map_w1(n0 + n, f8) : (n0 + n);
        if (f8) { u32x2 o; o.x = pk4_fp8(sp[0 * 33] * WSC, sp[1 * 33] * WSC, sp[2 * 33] * WSC, sp[3 * 33] * WSC); o.y = pk4_fp8(sp[4 * 33] * WSC, sp[5 * 33] * WSC, sp[6 * 33] * WSC, sp[7 * 33] * WSC);
            *(u32x2*)(WT8 + (size_t)drow * ldk + koff + k0 + 8 * c) = o; }
        else { u32x4 o; o.x = cvt_pk_bf16(sp[0 * 33], sp[1 * 33]); o.y = cvt_pk_bf16(sp[2 * 33], sp[3 * 33]); o.z = cvt_pk_bf16(sp[4 * 33], sp[5 * 33]); o.w = cvt_pk_bf16(sp[6 * 33], sp[7 * 33]);
            *(u32x4*)(WTb + (size_t)drow * ldk + koff + k0 + 8 * c) = o;
            u32x2 o8; o8.x = pk4_fp8(sp[0 * 33] * WSC, sp[1 * 33] * WSC, sp[2 * 33] * WSC, sp[3 * 33] * WSC); o8.y = pk4_fp8(sp[4 * 33] * WSC, sp[5 * 33] * WSC, sp[6 * 33] * WSC, sp[7 * 33] * WSC);
            *(u32x2*)(WT8 + (size_t)(NF8 + drow) * ldk + koff + k0 + 8 * c) = o8; } }
    asm volatile("s_waitcnt lgkmcnt(0)" ::: "memory");
}

__device__ __forceinline__ int crow(int r, int hi) { return (r & 3) + 8 * (r >> 2) + 4 * hi; }
template <bool SAMPLE>
__device__ __forceinline__ void attn_sub(const bf16_t* __restrict__ Qb, const bf16_t* __restrict__ ZA, unsigned char* __restrict__ YA, const float* __restrict__ sinks,
                                         LAS const unsigned char* kbase, int krow0, LAS const unsigned char* vbase, int vrowb, int vcol0,
                                         int rowbase, int headbase, int i0, bool firstblk, int lane, LAS unsigned char* oscr) {
    const int q = lane & 31, hi = lane >> 5;
    const int head = SAMPLE ? headbase + (q >> 3) : headbase;
    const int qi = SAMPLE ? (q & 7) : i0 + q;
    const size_t qoff = SAMPLE ? (size_t)(rowbase + (q & 7)) * 1024 + head * 64 : (size_t)(rowbase + q) * 1024 + head * 64;
    const float sl2 = __builtin_amdgcn_exp2f(-0.5f * (float)(head + 1)) * LOG2E;
    const float sink2 = sinks[head] * LOG2E;
    bf16x8 qf[4];
#pragma unroll
    for (int ks = 0; ks < 4; ++ks) qf[ks] = *(const bf16x8*)(Qb + qoff + ks * 16 + hi * 8);
    const int qrel = SAMPLE ? (q & 7) : q, th = qrel - 4 * hi;
    const float nb = -sl2 * (float)(128 + th);
    f32x16 s[5];
#pragma unroll
    for (int T = 0; T < 5; ++T) {
#pragma unroll
        for (int r = 0; r < 16; ++r) s[T][r] = sl2 * (float)(32 * T + (r & 3) + 8 * (r >> 2)) + nb;
        const int krow = krow0 + 32 * T + q;
        LAS const unsigned char* kp = kbase + krow * 128;
#pragma unroll
        for (int ks = 0; ks < 4; ++ks) {
            const bf16x8 kf = *(LAS const bf16x8*)(kp + (((2 * ks + hi) ^ (krow & 7)) * 16));
            s[T] = __builtin_amdgcn_mfma_f32_32x32x16_bf16(kf, qf[ks], s[T], 0, 0, 0);
        }
    }
    float mx = sink2;
#pragma unroll
    for (int T = 0; T < 5; ++T) {
        const bool dead = firstblk && (i0 + 32 * T < 128);
#pragma unroll
        for (int r = 0; r < 16; ++r) {
            const int cr = (r & 3) + 8 * (r >> 2);
            bool valid = !dead;
            if (T == 0) valid = valid && (cr >= th);
            if (T == 4) valid = valid && (cr <= th);
            const float v = valid ? s[T][r] : -1e30f;
            s[T][r] = v; mx = fmaxf(mx, v);
        }
        __builtin_amdgcn_sched_barrier(0);
    }
    mx = fmaxf(mx, __shfl_xor(mx, 32));
    float sum = 0.f;
#pragma unroll
    for (int T = 0; T < 5; ++T)
#pragma unroll
        for (int r = 0; r < 16; ++r) { const float p = __builtin_amdgcn_exp2f(s[T][r] - mx); s[T][r] = p; sum += p; }
    sum += __shfl_xor(sum, 32);
    const float inv = 1.0f / (sum + __builtin_amdgcn_exp2f(sink2 - mx));
    f32x16 o[2];
#pragma unroll
    for (int r = 0; r < 16; ++r) { o[0][r] = 0.f; o[1][r] = 0.f; }
#pragma unroll
    for (int T = 0; T < 5; ++T)
#pragma unroll
        for (int st = 0; st < 2; ++st) {
            u32x4 pw;
            pw.x = cvt_pk_bf16(s[T][8 * st + 0] * inv, s[T][8 * st + 1] * inv); pw.y = cvt_pk_bf16(s[T][8 * st + 2] * inv, s[T][8 * st + 3] * inv);
            pw.z = cvt_pk_bf16(s[T][8 * st + 4] * inv, s[T][8 * st + 5] * inv); pw.w = cvt_pk_bf16(s[T][8 * st + 6] * inv, s[T][8 * st + 7] * inv);
            const bf16x8 pf = __builtin_bit_cast(bf16x8, pw);
#pragma unroll
            for (int dt = 0; dt < 2; ++dt) {
                LAS const unsigned char* vp = vbase + (32 * dt + q) * vrowb + (vcol0 + 32 * T + 16 * st + 4 * hi) * 2;
                const s16x4 lo = *(LAS const s16x4*)vp, h4 = *(LAS const s16x4*)(vp + 16);
                const bf16x8 vf = (bf16x8){lo[0], lo[1], lo[2], lo[3], h4[0], h4[1], h4[2], h4[3]};
                o[dt] = __builtin_amdgcn_mfma_f32_32x32x16_bf16(pf, vf, o[dt], 0, 0, 0);
            }
        }
    {
        LAS float* osc = (LAS float*)oscr;
#pragma unroll
        for (int r = 0; r < 16; ++r) { const int qq = crow(r, hi); osc[qq * 68 + q] = o[0][r]; osc[qq * 68 + 32 + q] = o[1][r]; }
        asm volatile("s_waitcnt lgkmcnt(0)" ::: "memory");
        const int rq = lane >> 1, hf = lane & 1;
        const size_t orow = SAMPLE ? (size_t)(rowbase + (rq & 7)) : (size_t)(rowbase + rq);
        const size_t ocol = (SAMPLE ? (size_t)(headbase + (rq >> 3)) * 64 : (size_t)headbase * 64) + (size_t)hf * 32;
        const u32x4* zp = (const u32x4*)(ZA + orow * 1024 + ocol);
        u32x4 zw[4];
#pragma unroll
        for (int k = 0; k < 4; ++k) zw[k] = zp[k];
        unsigned w8[8];
#pragma unroll
        for (int k = 0; k < 8; ++k) {
            const f32x4 ov = *(LAS const f32x4*)(osc + rq * 68 + hf * 32 + 4 * k);
            const unsigned ga = zw[k >> 1][(k & 1) * 2], gb2 = zw[k >> 1][(k & 1) * 2 + 1];
            w8[k] = pk4_fp8(ov[0] * bf_lo(ga) * YASC, ov[1] * bf_hi(ga) * YASC, ov[2] * bf_lo(gb2) * YASC, ov[3] * bf_hi(gb2) * YASC);
        }
        u32x4* yp = (u32x4*)(YA + orow * 2048 + ocol);
        yp[0] = (u32x4){w8[0], w8[1], w8[2], w8[3]}; yp[1] = (u32x4){w8[4], w8[5], w8[6], w8[7]};
        asm volatile("s_waitcnt lgkmcnt(0)" ::: "memory");
    }
}

#define XB_TMO      128
#define XB_XCNT(j)  (256  + 64 * (j))
#define XB_XSUB(j)  (1280 + 64 * (j))
#define XB_XGEN(j)  (2304 + 64 * (j))
#define XB_TOP      3328
#define XB_TOPGEN   3392
#define XCD_BAR_WORDS 3456
#define XB_SPIN_CAP (1u << 18)
__device__ __forceinline__ unsigned xb_ld(unsigned* p)              { return __hip_atomic_load(p, __ATOMIC_RELAXED, __HIP_MEMORY_SCOPE_AGENT); }
__device__ __forceinline__ unsigned xb_add(unsigned* p, unsigned v) { return __hip_atomic_fetch_add(p, v, __ATOMIC_RELAXED, __HIP_MEMORY_SCOPE_AGENT); }
__device__ __forceinline__ unsigned xb_xcc_id() { return (unsigned)__builtin_amdgcn_s_getreg((3 << 11) | 20) & 0xFu; }
#define XB_SPIN(cond, bar) do { unsigned _sp = 0; while (cond) { __builtin_amdgcn_s_sleep(1); \
    if ((++_sp & 255u) == 0u) { if (xb_ld(&(bar)[XB_TMO])) break; if (_sp > XB_SPIN_CAP) { atomicAdd(&(bar)[XB_TMO], 1u); break; } } } } while (0)
struct XcdBarrier { unsigned* bar; unsigned x; volatile LAS unsigned* st; };
__device__ __forceinline__ XcdBarrier xcd_barrier_post(unsigned* bar, volatile LAS unsigned* st) {
    XcdBarrier b; b.bar = bar; b.x = xb_xcc_id(); b.st = st;
    if (threadIdx.x == 0) (void)xb_add(&bar[XB_XCNT(b.x)], 1u);
    return b;
}
__device__ __forceinline__ void xcd_barrier_complete(unsigned* bar, unsigned x, unsigned& nloc, unsigned& nx) {
    const unsigned G = gridDim.x * gridDim.y * gridDim.z;
    unsigned sum, cnt, mine, sp = 0u;
    for (;;) {
        sum = 0u; cnt = 0u; mine = 0u;
#pragma unroll
        for (unsigned j = 0; j < 16; ++j) { const unsigned c = xb_ld(&bar[XB_XCNT(j)]); sum += c; cnt += (c > 0u) ? 1u : 0u; mine = (j == x) ? c : mine; }
        if (sum == G) break;
        __builtin_amdgcn_s_sleep(1);
        if ((++sp & 255u) == 0u) { if (xb_ld(&bar[XB_TMO])) break; if (sp > XB_SPIN_CAP) { atomicAdd(&bar[XB_TMO], 1u); break; } }
    }
    nloc = mine > 0u ? mine : 1u; nx = cnt > 0u ? cnt : 1u;
}
__device__ __forceinline__ void xcd_barrier(const XcdBarrier& b) {
    asm volatile("s_waitcnt vmcnt(0)" ::: "memory");
    __syncthreads();
    if (threadIdx.x == 0) {
        unsigned* bar = b.bar;
        __builtin_amdgcn_s_waitcnt(0);
        unsigned nloc = b.st[0], nx = b.st[1];
        if (nloc == 0u) { xcd_barrier_complete(bar, b.x, nloc, nx); b.st[0] = nloc; b.st[1] = nx; }
        const unsigned old = xb_add(&bar[XB_XSUB(b.x)], 1u);
        const unsigned gen = old / nloc;
        if (old + 1u == (gen + 1u) * nloc) {
            __builtin_amdgcn_fence(__ATOMIC_RELEASE, "agent");
            asm volatile("s_waitcnt vmcnt(0)" ::: "memory");
            const unsigned og = xb_add(&bar[XB_TOP], 1u);
            const unsigned tg = og / nx;
            if (og + 1u == (tg + 1u) * nx) xb_add(&bar[XB_TOPGEN], 1u);
            else XB_SPIN(xb_ld(&bar[XB_TOPGEN]) == tg, bar);
            __builtin_amdgcn_fence(__ATOMIC_ACQUIRE, "agent");
            xb_add(&bar[XB_XGEN(b.x)], 1u);
            asm volatile("s_waitcnt vmcnt(0)" ::: "memory");
        } else {
            XB_SPIN(xb_ld(&bar[XB_XGEN(b.x)]) == gen, bar);
            __builtin_amdgcn_fence(__ATOMIC_ACQUIRE, "agent");
            asm volatile("s_waitcnt vmcnt(0)" ::: "memory");
        }
    }
    __syncthreads();
}

struct Args { const float* in[13]; float* out; unsigned char* ws; };

__global__ void __launch_bounds__(512, 2) hybrid_fwd(Args a) {
    extern __shared__ __attribute__((aligned(16))) unsigned char lds_raw[];
    LAS unsigned char* lds = (LAS unsigned char*)lds_raw;
    cg::grid_group grid = cg::this_grid();
    const int tid = threadIdx.x, lane = tid & 63, wave = __builtin_amdgcn_readfirstlane(tid >> 6);
    const int G = gridDim.x, c = blockIdx.x;
    unsigned char* ws = a.ws;
    bf16_t* W1B = (bf16_t*)(ws + W_W1B); unsigned char* W18 = ws + W_W18; unsigned char* W2T = ws + W_W2T; unsigned char* W3T = ws + W_W3T;
    bf16_t* XB = (bf16_t*)(ws + W_XB); unsigned char* MG = (unsigned char*)XB; unsigned char* X8 = ws + W_X8;
    bf16_t* Sb = (bf16_t*)(ws + W_S); bf16_t* Ub = (bf16_t*)(ws + W_U); bf16_t* Qb = (bf16_t*)(ws + W_Q); bf16_t* Kb = (bf16_t*)(ws + W_K); bf16_t* Vb = (bf16_t*)(ws + W_V);
    bf16_t* ZA = (bf16_t*)(ws + W_ZA); bf16_t* GC = (bf16_t*)(ws + W_GC); bf16_t* GA = (bf16_t*)(ws + W_GA);
    unsigned char* YC = ws + W_YCA; unsigned char* YA = YC + 1024;
    float* out = a.out;

    for (int i = tid; i < LDS_BYTES / 16; i += 512) ((LAS u32x4*)lds)[i] = (u32x4){0u, 0u, 0u, 0u};
    __syncthreads();
    (void)xcd_barrier_post((unsigned*)(ws + W_CTL), (volatile LAS unsigned*)(lds + LDS_BYTES - 64));
#define GRID_BAR() do { XcdBarrier xb_; xb_.bar = (unsigned*)(a.ws + W_CTL); xb_.x = xb_xcc_id(); xb_.st = (volatile LAS unsigned*)(lds + LDS_BYTES - 64); xcd_barrier(xb_); } while (0)

    {
        LAS float* scr = (LAS float*)(lds + wave * 16384);
        const int gw = c * 8 + wave, NGW = G * 8;
        constexpr int I1 = (DM / 64) * (NIN / 32), I2 = (1024 / 64) * (DM / 32), I3 = (DM / 64) * (DM / 32);
        const size_t n8 = (size_t)MT * DM / 8, n8p = (size_t)MP * DM / 8, stride = (size_t)G * 512;
        size_t i0 = (size_t)c * 512 + tid; int it = gw;
        for (;;) {
            const bool ht = it < I1 + 2 * I2 + I3;
            if (!ht && i0 >= n8) break;
            f32x4 v0[8], v1[8];
#pragma unroll
            for (int uu = 0; uu < 8; ++uu) { const size_t i = i0 + uu * stride;
                if (i < n8) { const float* src = (i < n8p) ? a.in[0] + i * 8 : a.in[1] + (i - n8p) * 8; v0[uu] = __builtin_nontemporal_load((const f32x4*)src); v1[uu] = __builtin_nontemporal_load((const f32x4*)(src + 4)); } }
            if (ht) {
                int r = it;
                if (r < I1) transpose_item<1>(a.in[5], DM, NIN, W1B, W18, DM, 0, scr, r, lane);
                else if ((r -= I1) < I2) transpose_item<0>(a.in[8], 1024, DM, nullptr, W2T, DM, 0, scr, r, lane);
                else if ((r -= I2) < I2) transpose_item<0>(a.in[9], 1024, DM, nullptr, W2T, DM, 1024, scr, r, lane);
                else transpose_item<0>(a.in[10], DM, DM, nullptr, W3T, DM, 0, scr, r - I2, lane);
                it += NGW;
            }
#pragma unroll
            for (int uu = 0; uu < 8; ++uu) { const size_t i = i0 + uu * stride;
                if (i < n8) {
                    u32x4 w; w.x = cvt_pk_bf16(v0[uu][0], v0[uu][1]); w.y = cvt_pk_bf16(v0[uu][2], v0[uu][3]); w.z = cvt_pk_bf16(v1[uu][0], v1[uu][1]); w.w = cvt_pk_bf16(v1[uu][2], v1[uu][3]);
                    { const int row = (int)(i >> 8); if (row >= MP || ((row >> 8) & 7) == 7) *(u32x4*)(XB + i * 8) = w; }
                    u32x2 w8; w8.x = pk4_fp8(v0[uu][0] * XSC, v0[uu][1] * XSC, v0[uu][2] * XSC, v0[uu][3] * XSC); w8.y = pk4_fp8(v1[uu][0] * XSC, v1[uu][1] * XSC, v1[uu][2] * XSC, v1[uu][3] * XSC);
                    *(u32x2*)(X8 + i * 8) = w8; } }
            i0 += 8 * stride;
        }
    }
    if (a.ws == nullptr) grid.sync();
    GRID_BAR();

    {
        {
            pg8::Gemm g{XB, W1B, MT, NB16, DM, 0, 0, DM}; pg8::CritOrder S{G, c};
            Epi1b E{Ub, Kb, Vb, out};
            pg8::gemm_phase<Epi1b, pg8::CritOrder, false>(lds, g, S, E);
        }
        {
            pg8::Gemm g{(const bf16_t*)X8, (const bf16_t*)W18, MT, NF8 + NB16, DM / 2, 0, 0, DM / 2}; pg8::F8Order S; S.so.init(MT, NF8, G, c); S.c0 = 120 % G;
            Epi1f E{ws, Sb};
            pg8::gemm_phase<Epi1f, pg8::F8Order, true>(lds, g, S, E);
        }
    }
    GRID_BAR();

    {
        u32x4 kr[4], vr[4];
#define ATT_STAGE_LOAD(UN) do { const int kvh_ = (UN) & 3, qb_ = ((UN) >> 2) & 15, b_ = (UN) >> 6, rowK0_ = b_ * SEQ + (qb_ - 1) * 128; \
        _Pragma("unroll") for (int it = 0; it < 4; ++it) { const int id = tid + 512 * it, j = id >> 3, cc = id & 7; \
            kr[it] = (u32x4){0u, 0u, 0u, 0u}; vr[it] = kr[it]; \
            if (qb_ > 0 || j >= 128) { kr[it] = *(const u32x4*)(Kb + (size_t)(rowK0_ + j) * 256 + kvh_ * 64 + cc * 8); vr[it] = *(const u32x4*)(Vb + (size_t)(rowK0_ + j) * 256 + kvh_ * 64 + cc * 8); } } } while (0)
        if ((c & 1) == 0) {
        if (c < 512) ATT_STAGE_LOAD(c);
        const float* cw = a.in[6]; const float* st = a.in[4];
        const size_t NIT = (size_t)(MT / 4) * 128, NA = (G == 256) ? (NIT * 5 / 14) & ~(size_t)65535 : 0;
        const bool grpA = (G == 256) && c < 128;
        const size_t cbeg = grpA ? (size_t)c * 512 + tid : NA + (size_t)((G == 256) ? c - 128 : c) * 512 + tid, cend = grpA ? NA : NIT, cstr = (size_t)((G == 256) ? 128 : G) * 512;
        for (size_t it = cbeg; it < cend; it += cstr) {
            const int r0 = (int)(it >> 7) * 4, ch = (int)(it & 127) * 8;
            u32x4 uw[6], sw[4];
#pragma unroll
            for (int k = 0; k < 6; ++k) { const int rr = (r0 + k - 2 < 0) ? 0 : r0 + k - 2; uw[k] = *(const u32x4*)(Ub + (size_t)rr * 1024 + ch); }
#pragma unroll
            for (int k = 0; k < 4; ++k) sw[k] = *(const u32x4*)(Sb + (size_t)(r0 + k) * 1024 + ch);
            float w0[8], w1[8], w2[8];
#pragma unroll
            for (int h4 = 0; h4 < 2; ++h4) { const f32x4 a0 = *(const f32x4*)(cw + ch + 4 * h4), a1 = *(const f32x4*)(cw + 1024 + ch + 4 * h4), a2 = *(const f32x4*)(cw + 2048 + ch + 4 * h4);
#pragma unroll
                for (int e = 0; e < 4; ++e) { w0[4 * h4 + e] = a0[e]; w1[4 * h4 + e] = a1[e]; w2[4 * h4 + e] = a2[e]; } }
#pragma unroll
            for (int k = 0; k < 4; ++k) {
                const int row = r0 + k;
                float u0[8], u1[8], u2[8], sv[8];
#define UNP(dst, SRC_) do { const u32x4 q_ = (SRC_); dst[0] = bf_lo(q_[0]); dst[1] = bf_hi(q_[0]); dst[2] = bf_lo(q_[1]); dst[3] = bf_hi(q_[1]); dst[4] = bf_lo(q_[2]); dst[5] = bf_hi(q_[2]); dst[6] = bf_lo(q_[3]); dst[7] = bf_hi(q_[3]); } while (0)
                UNP(u0, uw[k]); UNP(u1, uw[k + 1]); UNP(u2, uw[k + 2]); UNP(sv, sw[k]);
#undef UNP
                int t; const float* sp = nullptr;
                if (row < MP) t = row & (SEQ - 1); else { const int r2 = row - MP; t = r2 & 7; sp = st + (size_t)(r2 >> 3) * 2048 + ch; }
                if (t < 1) {
#pragma unroll
                    for (int e = 0; e < 8; ++e) u1[e] = sp ? sp[1024 + e] : 0.f;
                }
                if (t < 2) {
#pragma unroll
                    for (int e = 0; e < 8; ++e) u0[e] = sp ? sp[t * 1024 + e] : 0.f;
                }
                float y[8];
#pragma unroll
                for (int e = 0; e < 8; ++e) y[e] = sv[e] * (w0[e] * u0[e] + w1[e] * u1[e] + w2[e] * u2[e]);
                u32x2 w; w.x = pk4_fp8(y[0] * YCSC, y[1] * YCSC, y[2] * YCSC, y[3] * YCSC); w.y = pk4_fp8(y[4] * YCSC, y[5] * YCSC, y[6] * YCSC, y[7] * YCSC);
                *(u32x2*)(YC + (size_t)row * 2048 + ch) = w;
            }
        }
        const float* sinks = a.in[7];
        LAS unsigned char* ldsV = lds + 32768;
        for (int un = c; un < 512; un += G) {
            const int kvh = un & 3, qb = (un >> 2) & 15, b = un >> 6;
            __syncthreads();
#pragma unroll
            for (int it = 0; it < 4; ++it) {
                const int id = tid + 512 * it, j = id >> 3, cc = id & 7;
                const u32x4 kv = kr[it], vv = vr[it];
                *(LAS u32x4*)(lds + j * 128 + ((cc ^ (j & 7)) * 16)) = kv;
                LAS unsigned short* vt = (LAS unsigned short*)(ldsV + (cc * 8) * 520 + j * 2);
                vt[0 * 260] = (unsigned short)(vv.x & 0xffffu); vt[1 * 260] = (unsigned short)(vv.x >> 16); vt[2 * 260] = (unsigned short)(vv.y & 0xffffu); vt[3 * 260] = (unsigned short)(vv.y >> 16);
                vt[4 * 260] = (unsigned short)(vv.z & 0xffffu); vt[5 * 260] = (unsigned short)(vv.z >> 16); vt[6 * 260] = (unsigned short)(vv.w & 0xffffu); vt[7 * 260] = (unsigned short)(vv.w >> 16);
            }
            if (un + G < 512) ATT_STAGE_LOAD(un + G);
            __syncthreads();
            if (wave >= 4) __builtin_amdgcn_s_sleep(31);
#pragma unroll 1
            for (int sbi = 0; sbi < 2; ++sbi) {
                const int sb = wave + 8 * sbi, gq = sb >> 2, i0 = (sb & 3) * 32;
                attn_sub<false>(Qb, ZA, YA, sinks, lds, i0, ldsV, 520, i0, b * SEQ + qb * 128 + i0, kvh * 4 + gq, i0, qb == 0, lane, lds + 66048 + wave * 8704);
            }
        }
        for (int b = c; b < 128; b += G) {
            __syncthreads();
            {
                const int kvh = wave & 3;
                LAS unsigned char* kl = lds + kvh * 35088; LAS unsigned char* vl = kl + 17408;
                if (wave < 4 && lane < 4) *(LAS u32x4*)(vl + 64 * 272 + lane * 16) = (u32x4){0u, 0u, 0u, 0u};
                const float* ck = a.in[2]; const float* cv = a.in[3];
#pragma unroll 1
                for (int itb = (wave >> 2) * 8; itb < (wave >> 2) * 8 + 8; itb += 4) {
                    f32x4 k0s[4], k1s[4], v0s[4], v1s[4];
#pragma unroll
                    for (int u4 = 0; u4 < 4; ++u4) {
                        const int id = lane + 64 * (itb + u4), j = id >> 3, cc = id & 7;
                        const size_t so = ((size_t)(b * 128 + j) * 4 + kvh) * 64 + cc * 8;
                        k0s[u4] = *(const f32x4*)(ck + so); k1s[u4] = *(const f32x4*)(ck + so + 4); v0s[u4] = *(const f32x4*)(cv + so); v1s[u4] = *(const f32x4*)(cv + so + 4);
                    }
#pragma unroll
                    for (int u4 = 0; u4 < 4; ++u4) {
                        const int id = lane + 64 * (itb + u4), j = id >> 3, cc = id & 7;
                        const f32x4 k0 = k0s[u4], k1 = k1s[u4], v0 = v0s[u4], v1 = v1s[u4];
                        if (j >= 8) { const size_t dof = ((size_t)(b * 128 + j - 8) * 4 + kvh) * 64 + cc * 8;
                            *(f32x4*)(out + O_KS + dof) = k0; *(f32x4*)(out + O_KS + dof + 4) = k1; *(f32x4*)(out + O_VS + dof) = v0; *(f32x4*)(out + O_VS + dof + 4) = v1; }
                        u32x4 kw; kw.x = cvt_pk_bf16(k0[0], k0[1]); kw.y = cvt_pk_bf16(k0[2], k0[3]); kw.z = cvt_pk_bf16(k1[0], k1[1]); kw.w = cvt_pk_bf16(k1[2], k1[3]);
                        *(LAS u32x4*)(kl + j * 128 + ((cc ^ (j & 7)) * 16)) = kw;
                        const unsigned a0 = cvt_pk_bf16(v0[0], v0[1]), a1 = cvt_pk_bf16(v0[2], v0[3]), a2 = cvt_pk_bf16(v1[0], v1[1]), a3 = cvt_pk_bf16(v1[2], v1[3]);
                        LAS unsigned short* vt = (LAS unsigned short*)(vl + (cc * 8) * 272 + j * 2);
                        vt[0 * 136] = (unsigned short)(a0 & 0xffffu); vt[1 * 136] = (unsigned short)(a0 >> 16); vt[2 * 136] = (unsigned short)(a1 & 0xffffu); vt[3 * 136] = (unsigned short)(a1 >> 16);
                        vt[4 * 136] = (unsigned short)(a2 & 0xffffu); vt[5 * 136] = (unsigned short)(a2 >> 16); vt[6 * 136] = (unsigned short)(a3 & 0xffffu); vt[7 * 136] = (unsigned short)(a3 >> 16);
                    }
                }
                __syncthreads();
                if (wave < 4) {
                    const int jn = lane >> 3, cc = lane & 7, j = 128 + jn;
                    const u32x4 kv = *(const u32x4*)(Kb + (size_t)(MP + b * 8 + jn) * 256 + kvh * 64 + cc * 8), vv = *(const u32x4*)(Vb + (size_t)(MP + b * 8 + jn) * 256 + kvh * 64 + cc * 8);
                    *(LAS u32x4*)(kl + j * 128 + ((cc ^ (j & 7)) * 16)) = kv;
                    LAS unsigned short* vt = (LAS unsigned short*)(vl + (cc * 8) * 272 + j * 2);
                    vt[0 * 136] = (unsigned short)(vv.x & 0xffffu); vt[1 * 136] = (unsigned short)(vv.x >> 16); vt[2 * 136] = (unsigned short)(vv.y & 0xffffu); vt[3 * 136] = (unsigned short)(vv.y >> 16);
                    vt[4 * 136] = (unsigned short)(vv.z & 0xffffu); vt[5 * 136] = (unsigned short)(vv.z >> 16); vt[6 * 136] = (unsigned short)(vv.w & 0xffffu); vt[7 * 136] = (unsigned short)(vv.w >> 16);
                asm volatile("s_waitcnt lgkmcnt(0)" ::: "memory");
                attn_sub<true>(Qb, ZA, YA, sinks, kl, 0, vl, 272, 0, MP + b * 8, kvh * 4, 0, false, lane, kl + 128);
                }
            }
        }
        } else {
        if (c < 512) ATT_STAGE_LOAD(c);
        const float* sinks = a.in[7];
        LAS unsigned char* ldsV = lds + 32768;
        for (int un = c; un < 512; un += G) {
            const int kvh = un & 3, qb = (un >> 2) & 15, b = un >> 6;
            __syncthreads();
#pragma unroll
            for (int it = 0; it < 4; ++it) {
                const int id = tid + 512 * it, j = id >> 3, cc = id & 7;
                const u32x4 kv = kr[it], vv = vr[it];
                *(LAS u32x4*)(lds + j * 128 + ((cc ^ (j & 7)) * 16)) = kv;
                LAS unsigned short* vt = (LAS unsigned short*)(ldsV + (cc * 8) * 520 + j * 2);
                vt[0 * 260] = (unsigned short)(vv.x & 0xffffu); vt[1 * 260] = (unsigned short)(vv.x >> 16); vt[2 * 260] = (unsigned short)(vv.y & 0xffffu); vt[3 * 260] = (unsigned short)(vv.y >> 16);
                vt[4 * 260] = (unsigned short)(vv.z & 0xffffu); vt[5 * 260] = (unsigned short)(vv.z >> 16); vt[6 * 260] = (unsigned short)(vv.w & 0xffffu); vt[7 * 260] = (unsigned short)(vv.w >> 16);
            }
            if (un + G < 512) ATT_STAGE_LOAD(un + G);
            __syncthreads();
            if (wave >= 4) __builtin_amdgcn_s_sleep(31);
#pragma unroll 1
            for (int sbi = 0; sbi < 2; ++sbi) {
                const int sb = wave + 8 * sbi, gq = sb >> 2, i0 = (sb & 3) * 32;
                attn_sub<false>(Qb, ZA, YA, sinks, lds, i0, ldsV, 520, i0, b * SEQ + qb * 128 + i0, kvh * 4 + gq, i0, qb == 0, lane, lds + 66048 + wave * 8704);
            }
        }
        for (int b = c; b < 128; b += G) {
            __syncthreads();
            {
                const int kvh = wave & 3;
                LAS unsigned char* kl = lds + kvh * 35088; LAS unsigned char* vl = kl + 17408;
                if (wave < 4 && lane < 4) *(LAS u32x4*)(vl + 64 * 272 + lane * 16) = (u32x4){0u, 0u, 0u, 0u};
                const float* ck = a.in[2]; const float* cv = a.in[3];
#pragma unroll 1
                for (int itb = (wave >> 2) * 8; itb < (wave >> 2) * 8 + 8; itb += 4) {
                    f32x4 k0s[4], k1s[4], v0s[4], v1s[4];
#pragma unroll
                    for (int u4 = 0; u4 < 4; ++u4) {
                        const int id = lane + 64 * (itb + u4), j = id >> 3, cc = id & 7;
                        const size_t so = ((size_t)(b * 128 + j) * 4 + kvh) * 64 + cc * 8;
                        k0s[u4] = *(const f32x4*)(ck + so); k1s[u4] = *(const f32x4*)(ck + so + 4); v0s[u4] = *(const f32x4*)(cv + so); v1s[u4] = *(const f32x4*)(cv + so + 4);
                    }
#pragma unroll
                    for (int u4 = 0; u4 < 4; ++u4) {
                        const int id = lane + 64 * (itb + u4), j = id >> 3, cc = id & 7;
                        const f32x4 k0 = k0s[u4], k1 = k1s[u4], v0 = v0s[u4], v1 = v1s[u4];
                        if (j >= 8) { const size_t dof = ((size_t)(b * 128 + j - 8) * 4 + kvh) * 64 + cc * 8;
                            *(f32x4*)(out + O_KS + dof) = k0; *(f32x4*)(out + O_KS + dof + 4) = k1; *(f32x4*)(out + O_VS + dof) = v0; *(f32x4*)(out + O_VS + dof + 4) = v1; }
                        u32x4 kw; kw.x = cvt_pk_bf16(k0[0], k0[1]); kw.y = cvt_pk_bf16(k0[2], k0[3]); kw.z = cvt_pk_bf16(k1[0], k1[1]); kw.w = cvt_pk_bf16(k1[2], k1[3]);
                        *(LAS u32x4*)(kl + j * 128 + ((cc ^ (j & 7)) * 16)) = kw;
                        const unsigned a0 = cvt_pk_bf16(v0[0], v0[1]), a1 = cvt_pk_bf16(v0[2], v0[3]), a2 = cvt_pk_bf16(v1[0], v1[1]), a3 = cvt_pk_bf16(v1[2], v1[3]);
                        LAS unsigned short* vt = (LAS unsigned short*)(vl + (cc * 8) * 272 + j * 2);
                        vt[0 * 136] = (unsigned short)(a0 & 0xffffu); vt[1 * 136] = (unsigned short)(a0 >> 16); vt[2 * 136] = (unsigned short)(a1 & 0xffffu); vt[3 * 136] = (unsigned short)(a1 >> 16);
                        vt[4 * 136] = (unsigned short)(a2 & 0xffffu); vt[5 * 136] = (unsigned short)(a2 >> 16); vt[6 * 136] = (unsigned short)(a3 & 0xffffu); vt[7 * 136] = (unsigned short)(a3 >> 16);
                    }
                }
                __syncthreads();
                if (wave < 4) {
                    const int jn = lane >> 3, cc = lane & 7, j = 128 + jn;
                    const u32x4 kv = *(const u32x4*)(Kb + (size_t)(MP + b * 8 + jn) * 256 + kvh * 64 + cc * 8), vv = *(const u32x4*)(Vb + (size_t)(MP + b * 8 + jn) * 256 + kvh * 64 + cc * 8);
                    *(LAS u32x4*)(kl + j * 128 + ((cc ^ (j & 7)) * 16)) = kv;
                    LAS unsigned short* vt = (LAS unsigned short*)(vl + (cc * 8) * 272 + j * 2);
                    vt[0 * 136] = (unsigned short)(vv.x & 0xffffu); vt[1 * 136] = (unsigned short)(vv.x >> 16); vt[2 * 136] = (unsigned short)(vv.y & 0xffffu); vt[3 * 136] = (unsigned short)(vv.y >> 16);
                    vt[4 * 136] = (unsigned short)(vv.z & 0xffffu); vt[5 * 136] = (unsigned short)(vv.z >> 16); vt[6 * 136] = (unsigned short)(vv.w & 0xffffu); vt[7 * 136] = (unsigned short)(vv.w >> 16);
                asm volatile("s_waitcnt lgkmcnt(0)" ::: "memory");
                attn_sub<true>(Qb, ZA, YA, sinks, kl, 0, vl, 272, 0, MP + b * 8, kvh * 4, 0, false, lane, kl + 128);
                }
            }
        }
        const float* cw = a.in[6]; const float* st = a.in[4];
        const size_t NIT = (size_t)(MT / 4) * 128, NA = (G == 256) ? (NIT * 5 / 14) & ~(size_t)65535 : 0;
        const bool grpA = (G == 256) && c < 128;
        const size_t cbeg = grpA ? (size_t)c * 512 + tid : NA + (size_t)((G == 256) ? c - 128 : c) * 512 + tid, cend = grpA ? NA : NIT, cstr = (size_t)((G == 256) ? 128 : G) * 512;
        for (size_t it = cbeg; it < cend; it += cstr) {
            const int r0 = (int)(it >> 7) * 4, ch = (int)(it & 127) * 8;
            u32x4 uw[6], sw[4];
#pragma unroll
            for (int k = 0; k < 6; ++k) { const int rr = (r0 + k - 2 < 0) ? 0 : r0 + k - 2; uw[k] = *(const u32x4*)(Ub + (size_t)rr * 1024 + ch); }
#pragma unroll
            for (int k = 0; k < 4; ++k) sw[k] = *(const u32x4*)(Sb + (size_t)(r0 + k) * 1024 + ch);
            float w0[8], w1[8], w2[8];
#pragma unroll
            for (int h4 = 0; h4 < 2; ++h4) { const f32x4 a0 = *(const f32x4*)(cw + ch + 4 * h4), a1 = *(const f32x4*)(cw + 1024 + ch + 4 * h4), a2 = *(const f32x4*)(cw + 2048 + ch + 4 * h4);
#pragma unroll
                for (int e = 0; e < 4; ++e) { w0[4 * h4 + e] = a0[e]; w1[4 * h4 + e] = a1[e]; w2[4 * h4 + e] = a2[e]; } }
#pragma unroll
            for (int k = 0; k < 4; ++k) {
                const int row = r0 + k;
                float u0[8], u1[8], u2[8], sv[8];
#define UNP(dst, SRC_) do { const u32x4 q_ = (SRC_); dst[0] = bf_lo(q_[0]); dst[1] = bf_hi(q_[0]); dst[2] = bf_lo(q_[1]); dst[3] = bf_hi(q_[1]); dst[4] = bf_lo(q_[2]); dst[5] = bf_hi(q_[2]); dst[6] = bf_lo(q_[3]); dst[7] = bf_hi(q_[3]); } while (0)
                UNP(u0, uw[k]); UNP(u1, uw[k + 1]); UNP(u2, uw[k + 2]); UNP(sv, sw[k]);
#undef UNP
                int t; const float* sp = nullptr;
                if (row < MP) t = row & (SEQ - 1); else { const int r2 = row - MP; t = r2 & 7; sp = st + (size_t)(r2 >> 3) * 2048 + ch; }
                if (t < 1) {
#pragma unroll
                    for (int e = 0; e < 8; ++e) u1[e] = sp ? sp[1024 + e] : 0.f;
                }
                if (t < 2) {
#pragma unroll
                    for (int e = 0; e < 8; ++e) u0[e] = sp ? sp[t * 1024 + e] : 0.f;
                }
                float y[8];
#pragma unroll
                for (int e = 0; e < 8; ++e) y[e] = sv[e] * (w0[e] * u0[e] + w1[e] * u1[e] + w2[e] * u2[e]);
                u32x2 w; w.x = pk4_fp8(y[0] * YCSC, y[1] * YCSC, y[2] * YCSC, y[3] * YCSC); w.y = pk4_fp8(y[4] * YCSC, y[5] * YCSC, y[6] * YCSC, y[7] * YCSC);
                *(u32x2*)(YC + (size_t)row * 2048 + ch) = w;
            }
        }
        }
#undef ATT_STAGE_LOAD
        __syncthreads();
    }
    GRID_BAR();

    {
        pg8::Gemm g{(const bf16_t*)YC, (const bf16_t*)W2T, MT, DM, 512, 1024, 1024, DM / 2}; pg8::PairOrder S; S.so.init(MT, DM, G, c);
        Epi2 E{GC, GA, MG};
        pg8::gemm_phase<Epi2, pg8::PairOrder, true>(lds, g, S, E);
    }
    GRID_BAR();

    {
        pg8::Gemm g{(const bf16_t*)MG, (const bf16_t*)W3T, MT, DM, DM / 2, 0, 0, DM / 2}; pg8::StaticOrder S; S.init(MT, DM, G, c);
        Epi3 E{Sb};
        pg8::gemm_phase<Epi3, pg8::StaticOrder, true>(lds, g, S, E);
    }
    GRID_BAR();

    {
        f32x4 gg[8], bb[8];
#pragma unroll
        for (int j = 0; j < 8; ++j) { gg[j] = ((const f32x4*)a.in[11])[lane + 64 * j]; bb[j] = ((const f32x4*)a.in[12])[lane + 64 * j]; }
        for (int row = c * 8 + wave; row < MT; row += G * 8) {
            f32x4* zr = (f32x4*)(out + O_Y + (size_t)row * DM) + lane;
            const f32x4* xr = (const f32x4*)((row < MP) ? a.in[0] + (size_t)row * DM : a.in[1] + (size_t)(row - MP) * DM) + lane;
            const u32x2* orw = (const u32x2*)(Sb + (size_t)row * DM) + lane;
            f32x4 v[8]; float s = 0.f;
#pragma unroll
            for (int j = 0; j < 8; ++j) { const f32x4 xv = __builtin_nontemporal_load(xr + 64 * j); const u32x2 ow = orw[64 * j];
                v[j][0] = xv[0] * ALPHA + bf_lo(ow.x); v[j][1] = xv[1] * ALPHA + bf_hi(ow.x); v[j][2] = xv[2] * ALPHA + bf_lo(ow.y); v[j][3] = xv[3] * ALPHA + bf_hi(ow.y);
                s += (v[j][0] + v[j][1]) + (v[j][2] + v[j][3]); }
#pragma unroll
            for (int o = 1; o < 64; o <<= 1) s += __shfl_xor(s, o);
            const float mean = s * (1.f / DM); float s2 = 0.f;
#pragma unroll
            for (int j = 0; j < 8; ++j) { v[j] = v[j] - mean; s2 += (v[j][0] * v[j][0] + v[j][1] * v[j][1]) + (v[j][2] * v[j][2] + v[j][3] * v[j][3]); }
#pragma unroll
            for (int o = 1; o < 64; o <<= 1) s2 += __shfl_xor(s2, o);
            const float rstd = 1.0f / sqrtf(s2 * (1.f / DM) + LN_EPS);
#pragma unroll
            for (int j = 0; j < 8; ++j) __builtin_nontemporal_store(v[j] * rstd * gg[j] + bb[j], zr + 64 * j);
        }
    }
}

extern "C" void kernel_launch(void* const* d_in, const int* in_sizes, int n_in, void* d_out, int out_size, void* d_ws, size_t ws_size, hipStream_t stream) {
    static int grid_blocks = 0;
    if (grid_blocks == 0) {
        if (n_in != 13 || (size_t)out_size != O_END || ws_size < W_END) { fprintf(stderr, "kernel_launch: unexpected shapes (n_in %d, out %d, ws %zu)\n", n_in, out_size, ws_size); grid_blocks = -1; return; }
        int dev = 0, cus = 0, per_cu = 0;
        hipGetDevice(&dev);
        hipDeviceGetAttribute(&cus, hipDeviceAttributeMultiprocessorCount, dev);
        if (hipFuncSetAttribute((const void*)hybrid_fwd, hipFuncAttributeMaxDynamicSharedMemorySize, LDS_BYTES) != hipSuccess) { fprintf(stderr, "kernel_launch: hipFuncSetAttribute failed\n"); grid_blocks = -1; return; }
        if (hipOccupancyMaxActiveBlocksPerMultiprocessor(&per_cu, (const void*)hybrid_fwd, 512, LDS_BYTES) != hipSuccess || per_cu < 1) { fprintf(stderr, "kernel_launch: occupancy query failed (%d)\n", per_cu); (void)hipGetLastError(); per_cu = 1; }
        grid_blocks = cus * per_cu;
    }
    if (grid_blocks < 0) return;
    if (hipMemsetAsync((char*)d_ws + W_CTL, 0, CTL_BYTES, stream) != hipSuccess) { fprintf(stderr, "kernel_launch: hipMemsetAsync failed\n"); return; }
    Args a{};
    for (int i = 0; i < 13; ++i) a.in[i] = (const float*)d_in[i];
    a.out = (float*)d_out; a.ws = (unsigned char*)d_ws;
    void* args[] = {&a};
    hipError_t e = hipLaunchCooperativeKernel((const void*)hybrid_fwd, dim3(grid_blocks), dim3(512), args, LDS_BYTES, stream);
    if (e != hipSuccess) fprintf(stderr, "cooperative launch failed: %s (grid %d)\n", hipGetErrorString(e), grid_blocks);
}
```
